# Optimizing an MI355X kernel written in HIP

```python
import math
import jax, jax.numpy as jnp
from jax import lax
import numpy as np

D_MODEL = 2048
BATCH = 16
SEQ = 2048
DEPTH = 1

RMS_EPS = 1e-6
RWKV_WIDTH = D_MODEL // 2
RWKV_HEAD = 64
RWKV_HEADS = RWKV_WIDTH // RWKV_HEAD
DECAY_RANK = 64
AAA_RANK = 64
GATE_RANK = 160
RWKV_GN_EPS = 64e-5
S5_WIDTH = D_MODEL // 2
S5_GROUP = 16
S5_GROUPS = S5_WIDTH // S5_GROUP
S5_STATE = 64
DT_MIN = 1e-3
DT_MAX = 1e-1
N_GROUPS = 4
EXPERTS_PER_GROUP = 8
N_EXPERTS = N_GROUPS * EXPERTS_PER_GROUP
TOP_K_INNER = 2
D_EXPERT = D_MODEL // 4
RWKV_SPLITS = [RWKV_WIDTH, 2 * RWKV_WIDTH, 3 * RWKV_WIDTH, 3 * RWKV_WIDTH + DECAY_RANK, 3 * RWKV_WIDTH + DECAY_RANK + AAA_RANK]
RWKV_COLS = 3 * RWKV_WIDTH + DECAY_RANK + AAA_RANK + GATE_RANK
IN_SPLITS = [RWKV_COLS, RWKV_COLS + S5_WIDTH, RWKV_COLS + S5_WIDTH + D_MODEL]
IN_COLS = RWKV_COLS + S5_WIDTH + 2 * D_MODEL

kernel_name = "hybrid_rwkv7_s5_hmoe_block"


def rms_norm(x, g):
    xf = x.astype(jnp.float32)
    y = xf * lax.rsqrt(jnp.mean(xf * xf, axis=-1, keepdims=True) + RMS_EPS)
    return (y * g.astype(jnp.float32)).astype(x.dtype)


def token_shift(p, mu):
    prev = jnp.pad(p, ((0, 0), (1, 0), (0, 0)))[:, :-1]
    return p + (prev - p) * mu


def rwkv7_recurrence(r, w, k, v, a, b):
    Bn, T, H, N = r.shape
    seq = tuple(jnp.moveaxis(t, 1, 0) for t in (r, w, k, v, a, b))

    def step(S, inp):
        rt, wt, kt, vt, at, bt = inp
        sa = jnp.einsum('bhij,bhj->bhi', S, at)
        S = S * wt[:, :, None, :] + sa[..., None] * bt[:, :, None, :] + vt[..., None] * kt[:, :, None, :]
        y = jnp.einsum('bhij,bhj->bhi', S, rt)
        return S, y

    S0 = jnp.zeros((Bn, H, N, N), jnp.float32)
    _, ys = lax.scan(step, S0, seq)
    return jnp.moveaxis(ys, 0, 1)


def rwkv7_branch(p, mu, w0, w_up, a0, a_up, g_up, k_k, k_a, r_k, ln_w, ln_b, w_out):
    f32 = jnp.float32
    Bn, T, _ = p.shape
    heads = lambda t: t.reshape(Bn, T, RWKV_HEADS, RWKV_HEAD)
    p = token_shift(p, mu)
    r, k, v, xw, xa, xg = jnp.split(p, RWKV_SPLITS, axis=-1)
    w_log = -jax.nn.softplus(-(w0 + jnp.tanh(xw) @ w_up).astype(f32)) - 0.5
    decay = jnp.exp(-jnp.exp(w_log))
    a = jax.nn.sigmoid((a0 + xa @ a_up).astype(f32))
    g = jax.nn.sigmoid(xg) @ g_up
    k = k.astype(f32)
    kk = heads(k * k_k.astype(f32))
    kk = kk / jnp.maximum(jnp.linalg.norm(kk, axis=-1, keepdims=True), 1e-12)
    k = k * (1.0 + (a - 1.0) * k_a.astype(f32))
    rh, kh, vh = heads(r.astype(f32)), heads(k), heads(v.astype(f32))
    y = rwkv7_recurrence(rh, heads(decay), kh, vh, -kk, kk * heads(a))
    mean = jnp.mean(y, axis=-1, keepdims=True)
    var = jnp.mean(jnp.square(y - mean), axis=-1, keepdims=True)
    y = ((y - mean) * lax.rsqrt(var + RWKV_GN_EPS)).reshape(Bn, T, RWKV_WIDTH)
    y = y * ln_w.astype(f32) + ln_b.astype(f32)
    bonus = jnp.sum(rh * kh * r_k.astype(f32), axis=-1, keepdims=True) * vh
    y = y + bonus.reshape(Bn, T, RWKV_WIDTH)
    return (y * g.astype(f32)).astype(p.dtype) @ w_out


def s5_branch(u, lam_re, lam_im, log_step, b_re, b_im, c_re, c_im, d_skip, w_glu_v, w_glu_g):
    f32 = jnp.float32
    Bn, T, _ = u.shape
    uf = u.astype(f32).reshape(Bn, T, S5_GROUPS, S5_GROUP)
    lam = lax.complex(lam_re.astype(f32), lam_im.astype(f32))
    step = jnp.exp(log_step.astype(f32))[:, None]
    a_bar = jnp.exp(lam * step)
    b_bar = ((a_bar - 1.0) / lam)[..., None] * lax.complex(b_re.astype(f32), b_im.astype(f32))
    bu = lax.complex(jnp.einsum('btgh,gph->btgp', uf, jnp.real(b_bar)),
                     jnp.einsum('btgh,gph->btgp', uf, jnp.imag(b_bar)))
    a_elems = jnp.broadcast_to(a_bar, bu.shape)

    def combine(left, right):
        a_l, b_l = left
        a_r, b_r = right
        return a_r * a_l, a_r * b_l + b_r

    _, xs = lax.associative_scan(combine, (a_elems, bu), axis=1)
    y = (jnp.einsum('btgp,ghp->btgh', jnp.real(xs), c_re.astype(f32))
         - jnp.einsum('btgp,ghp->btgh', jnp.imag(xs), c_im.astype(f32))
         + d_skip.astype(f32).reshape(S5_GROUPS, S5_GROUP) * uf)
    z = jax.nn.gelu(y.reshape(Bn, T, S5_WIDTH)).astype(u.dtype)
    return (z @ w_glu_v) * jax.nn.sigmoid(z @ w_glu_g)


def hierarchical_moe(h, wr_group, br_group, wr_expert, br_expert, w_gate, w_up, w_down):
    f32 = jnp.float32
    Bn, T, D = h.shape
    n_tok = Bn * T
    ht = h.reshape(n_tok, D)
    group_prob = jax.nn.softmax((ht @ wr_group).astype(f32) + br_group.astype(f32), axis=-1)
    g_prob, g_idx = lax.top_k(group_prob, 1)
    expert_logits = ((ht @ wr_expert).astype(f32) + br_expert.astype(f32)).reshape(n_tok, N_GROUPS, EXPERTS_PER_GROUP)
    sel = expert_logits[jnp.arange(n_tok), g_idx[:, 0]]
    top_logit, top_idx = lax.top_k(sel, TOP_K_INNER)
    weights = jax.nn.softmax(top_logit, axis=-1) * g_prob
    expert_id = g_idx * EXPERTS_PER_GROUP + top_idx
    gates = jnp.sum(jax.nn.one_hot(expert_id, N_EXPERTS, dtype=f32) * weights[..., None], axis=1)
    out = jnp.zeros((n_tok, D), f32)
    for e in range(N_EXPERTS):
        hid = jax.nn.silu(ht @ w_gate[e]) * (ht @ w_up[e])
        out = out + gates[:, e:e + 1] * (hid @ w_down[e]).astype(f32)
    return out.astype(h.dtype).reshape(Bn, T, D)


def setup_inputs(seed: int = 0) -> dict:
    key = jax.random.key(seed)
    ks = jax.random.split(key, 40)
    f32 = jnp.float32
    L, D, W, H, N = DEPTH, D_MODEL, RWKV_WIDTH, RWKV_HEADS, RWKV_HEAD
    G, Hs, P = S5_GROUPS, S5_GROUP, S5_STATE

    def nrm(i, shape, scale):
        return scale * jax.random.normal(ks[i], shape, f32)

    ramp = jnp.arange(W, dtype=f32) / (W - 1)
    w0_init = -6.5 + 5.0 * ramp ** 0.85
    lam_im_init = jnp.pi * jnp.arange(P, dtype=f32)
    return {
        "x": nrm(0, (BATCH, SEQ, D), 1.0),
        "norm_mix_g": 1.0 + nrm(1, (L, D), 0.02),
        "w_in": nrm(2, (L, D, IN_COLS), D ** -0.5),
        "rwkv_mu": 0.5 + nrm(3, (L, RWKV_COLS), 0.1),
        "rwkv_w0": w0_init + nrm(4, (L, W), 0.05),
        "rwkv_w_up": nrm(5, (L, DECAY_RANK, W), 0.1 * DECAY_RANK ** -0.5),
        "rwkv_a0": nrm(6, (L, W), 0.1),
        "rwkv_a_up": nrm(7, (L, AAA_RANK, W), 0.1 * AAA_RANK ** -0.5),
        "rwkv_g_up": nrm(8, (L, GATE_RANK, W), GATE_RANK ** -0.5),
        "rwkv_k_k": 0.85 + nrm(9, (L, W), 0.02),
        "rwkv_k_a": 1.0 + nrm(10, (L, W), 0.02),
        "rwkv_r_k": nrm(11, (L, H, N), 0.1),
        "rwkv_ln_w": 1.0 + nrm(12, (L, W), 0.02),
        "rwkv_ln_b": nrm(13, (L, W), 0.02),
        "rwkv_w_out": nrm(14, (L, W, D), W ** -0.5),
        "s5_lam_re": -0.5 + nrm(15, (L, G, P), 0.01),
        "s5_lam_im": lam_im_init + nrm(16, (L, G, P), 0.01),
        "s5_log_step": jax.random.uniform(ks[17], (L, G), f32, math.log(DT_MIN), math.log(DT_MAX)),
        "s5_b_re": nrm(18, (L, G, P, Hs), (2 * Hs) ** -0.5),
        "s5_b_im": nrm(19, (L, G, P, Hs), (2 * Hs) ** -0.5),
        "s5_c_re": nrm(20, (L, G, Hs, P), (2 * P) ** -0.5),
        "s5_c_im": nrm(21, (L, G, Hs, P), (2 * P) ** -0.5),
        "s5_d": nrm(22, (L, S5_WIDTH), 1.0),
        "s5_w_glu_v": nrm(23, (L, S5_WIDTH, D), S5_WIDTH ** -0.5),
        "s5_w_glu_g": nrm(24, (L, S5_WIDTH, D), S5_WIDTH ** -0.5),
        "w_out": nrm(25, (L, D, D), D ** -0.5),
        "norm_ffn_g": 1.0 + nrm(26, (L, D), 0.02),
        "router_group_w": nrm(27, (L, D, N_GROUPS), D ** -0.5),
        "router_group_b": nrm(28, (L, N_GROUPS), 0.01),
        "router_expert_w": nrm(29, (L, D, N_EXPERTS), D ** -0.5),
        "router_expert_b": nrm(30, (L, N_EXPERTS), 0.01),
        "moe_w_gate": nrm(31, (L, N_EXPERTS, D, D_EXPERT), D ** -0.5),
        "moe_w_up": nrm(32, (L, N_EXPERTS, D, D_EXPERT), D ** -0.5),
        "moe_w_down": nrm(33, (L, N_EXPERTS, D_EXPERT, D), D_EXPERT ** -0.5),
        "norm_final_g": 1.0 + nrm(34, (D,), 0.02),
    }


def reference(x, norm_mix_g, w_in, rwkv_mu, rwkv_w0, rwkv_w_up, rwkv_a0, rwkv_a_up, rwkv_g_up,
              rwkv_k_k, rwkv_k_a, rwkv_r_k, rwkv_ln_w, rwkv_ln_b, rwkv_w_out,
              s5_lam_re, s5_lam_im, s5_log_step, s5_b_re, s5_b_im, s5_c_re, s5_c_im, s5_d,
              s5_w_glu_v, s5_w_glu_g, w_out, norm_ffn_g, router_group_w, router_group_b,
              router_expert_w, router_expert_b, moe_w_gate, moe_w_up, moe_w_down, norm_final_g):
    for l in range(DEPTH):
        h = rms_norm(x, norm_mix_g[l])
        proj = h @ w_in[l]
        p_rwkv, u, gate_a, gate_b = jnp.split(proj, IN_SPLITS, axis=-1)
        y_a = rwkv7_branch(p_rwkv, rwkv_mu[l], rwkv_w0[l], rwkv_w_up[l], rwkv_a0[l], rwkv_a_up[l],
                           rwkv_g_up[l], rwkv_k_k[l], rwkv_k_a[l], rwkv_r_k[l], rwkv_ln_w[l],
                           rwkv_ln_b[l], rwkv_w_out[l])
        y_b = s5_branch(u, s5_lam_re[l], s5_lam_im[l], s5_log_step[l], s5_b_re[l], s5_b_im[l],
                        s5_c_re[l], s5_c_im[l], s5_d[l], s5_w_glu_v[l], s5_w_glu_g[l])
        mixed = jax.nn.sigmoid(gate_a) * y_a + jax.nn.sigmoid(gate_b) * y_b
        x = x + mixed @ w_out[l]
        x = x + hierarchical_moe(rms_norm(x, norm_ffn_g[l]), router_group_w[l], router_group_b[l],
                                 router_expert_w[l], router_expert_b[l], moe_w_gate[l],
                                 moe_w_up[l], moe_w_down[l])
    return rms_norm(x, norm_final_g)
```

```cpp
#include <hip/hip_runtime.h>
#include <cstdio>
#include <cstdint>

namespace pg8 {
#define PG8_LAS __attribute__((address_space(3)))
typedef unsigned short bf16_t;
typedef short bf16x8 __attribute__((ext_vector_type(8)));
typedef float f32x4 __attribute__((ext_vector_type(4)));
typedef unsigned u32x4 __attribute__((ext_vector_type(4)));
typedef unsigned u32x2 __attribute__((ext_vector_type(2)));
constexpr int BM = 256, BK = 64, HALF = 128, HTB = HALF * BK * 2  , STAGE_BYTES = 8 * HTB, NXCD = 8, WGM = 8;

__host__ __device__ __forceinline__ int lds_byte(int r, int c) { const int st = (r >> 4) * 2 + (c >> 5), rr = r & 15, cc = c & 31, ob = rr * 64 + cc * 2; return st * 1024 + (ob ^ (((ob >> 9) & 1) << 5)); }
__host__ __device__ __forceinline__ void stage_rc(int b, int& R, int& C) { const int st = b / 1024, sb = b % 1024, swz = sb ^ (((sb >> 9) & 1) << 5); R = (st >> 1) * 16 + swz / 64; C = (st & 1) * 32 + (swz % 64) / 2; }
__host__ __device__ __forceinline__ int perm32(int rho) { const int n = rho >> 4, i = rho & 15; return 8 * (i >> 2) + 4 * n + (i & 3); }

struct Unit { int pm, pn, e, rt; };
struct Gemm { const void* A; const void* Bt; int K; int sa, sb; };
typedef int v8i32 __attribute__((ext_vector_type(8)));

struct StaticOrder {
    int nM, nN, nwg, G, c;
    __host__ __device__ void init(int M, int N, int G_, int c_) { nM = M / BM; nN = N / BM; nwg = nM * nN; G = G_; c = c_; }
    __host__ __device__ bool next(int i, Unit& u) const {
        const long L = (long)i * G + c; if (L >= nwg) return false;
        int wgid = (int)L; { const int q = nwg / NXCD, r = nwg % NXCD, xcd = wgid % NXCD, off = wgid / NXCD; wgid = (xcd < r ? xcd * (q + 1) : r * (q + 1) + (xcd - r) * q) + off; }
        const int nig = WGM * nN, gid = wgid / nig, fm = gid * WGM, gsz = (nM - fm) < WGM ? (nM - fm) : WGM;
        u.pm = fm + ((wgid % nig) % gsz); u.pn = (wgid % nig) / gsz; u.e = 0; u.rt = 0; return true;
    }
    __device__ __forceinline__ int arow(const Unit& u, int r) const { return u.pm * BM + r; }
};

typedef float f32x2_ __attribute__((ext_vector_type(2))); typedef __bf16 bf16x2_ __attribute__((ext_vector_type(2)));
__device__ __forceinline__ unsigned cvt_pk_bf16(float lo, float hi) { const f32x2_ v = {lo, hi}; return __builtin_bit_cast(unsigned, __builtin_convertvector(v, bf16x2_)); }

template <class Epi, class Sched, bool ALIGN_EPI, bool FP8 = false>
__device__ __forceinline__ void gemm_phase(PG8_LAS unsigned char* lds, const Gemm g, const Sched& S, const Epi& E) {
    const int tid = threadIdx.x, wid = __builtin_amdgcn_readfirstlane(tid >> 6), lane = tid & 63, wr = wid >> 2, wc = wid & 3, fr = lane & 15, fq = lane >> 4;
    constexpr int EB = FP8 ? 1 : 2;
    const int K = g.K, nt = K * EB / (BK * 2);
    int RA[2]; unsigned coffA[2], voffB[2];
#pragma unroll
    for (int i = 0; i < 2; ++i) { int R, C; stage_rc(tid * 16 + i * 8192, R, C); const int Rb = Epi::PERM ? ((R & ~31) + perm32(R & 31)) : R;
        RA[i] = R; coffA[i] = (unsigned)C * 2u; voffB[i] = (unsigned)(Rb * K) * (unsigned)EB + (unsigned)C * 2u; }
    const unsigned rowb = (unsigned)K * (unsigned)EB;
    const size_t kstep = (size_t)(BK * 2);
    const size_t hstep = (size_t)HALF * K * EB;
    const size_t tstep = 2 * hstep;
    const unsigned ldsw = (unsigned)wid * 1024u;
    const int aoff = lds_byte(wr * 64 + fr, FP8 ? fq * 16 : fq * 8), boff = lds_byte(wc * 32 + fr, FP8 ? fq * 16 : fq * 8);
    constexpr int KS2 = FP8 ? 16 : 1024;
    const char* gA = (const char*)g.A;
#define PG8_SA(b, h) (((b) * 2 + (h)) * HTB)
#define PG8_SB(b, h) ((4 + (b) * 2 + (h)) * HTB)
#define PG8_STAGE(bufoff, gbase, voff) do { _Pragma("unroll") for (int _i = 0; _i < 2; ++_i) \
        __builtin_amdgcn_global_load_lds((const unsigned*)((const char*)(gbase) + (voff)[_i]), (PG8_LAS unsigned*)(lds + (bufoff) + ldsw + _i * 8192), 16, 0, 0); } while (0)
#define PG8_LDA(dst, b, h) do { _Pragma("unroll") for (int m = 0; m < 4; ++m) _Pragma("unroll") for (int k = 0; k < 2; ++k) dst[m][k] = *(const PG8_LAS bf16x8*)(lds + PG8_SA(b, h) + aoff + m * 2048 + k * KS2); } while (0)
#define PG8_LDB(dst, b, h) do { _Pragma("unroll") for (int n = 0; n < 2; ++n) _Pragma("unroll") for (int k = 0; k < 2; ++k) dst[n][k] = *(const PG8_LAS bf16x8*)(lds + PG8_SB(b, h) + boff + n * 2048 + k * KS2); } while (0)
#define PG8_MMA(ai, bj, At, Bt) do { __builtin_amdgcn_s_setprio(1); _Pragma("unroll") for (int m = 0; m < 4; ++m) _Pragma("unroll") for (int n = 0; n < 2; ++n) { \
        if constexpr (FP8) { const u32x4 _b0 = __builtin_bit_cast(u32x4, Bt[n][0]), _b1 = __builtin_bit_cast(u32x4, Bt[n][1]), _a0 = __builtin_bit_cast(u32x4, At[m][0]), _a1 = __builtin_bit_cast(u32x4, At[m][1]); \
            acc[ai][bj][m][n] = __builtin_amdgcn_mfma_scale_f32_16x16x128_f8f6f4((v8i32){(int)_b0.x, (int)_b0.y, (int)_b0.z, (int)_b0.w, (int)_b1.x, (int)_b1.y, (int)_b1.z, (int)_b1.w}, \
                (v8i32){(int)_a0.x, (int)_a0.y, (int)_a0.z, (int)_a0.w, (int)_a1.x, (int)_a1.y, (int)_a1.z, (int)_a1.w}, acc[ai][bj][m][n], 0, 0, 0, g.sb, 0, g.sa); } \
        else { _Pragma("unroll") for (int k = 0; k < 2; ++k) acc[ai][bj][m][n] = __builtin_amdgcn_mfma_f32_16x16x32_bf16(Bt[n][k], At[m][k], acc[ai][bj][m][n], 0, 0, 0); } } \
        __builtin_amdgcn_s_setprio(0); } while (0)
#define PG8_WAIT_V(n) asm volatile("s_waitcnt vmcnt(" #n ")" ::: "memory")
#define PG8_WAIT_L(n) asm volatile("s_waitcnt lgkmcnt(" #n ")" ::: "memory")
#define PG8_BAR __builtin_amdgcn_s_barrier()
#define PG8_SCHED __builtin_amdgcn_sched_barrier(0)
    Unit cur, nxt; int ui = 0;
    if (!S.next(0, cur)) return;
    f32x4 acc[2][2][4][2];
#pragma unroll
    for (int a = 0; a < 2; ++a)
#pragma unroll
        for (int b = 0; b < 2; ++b)
#pragma unroll
            for (int m = 0; m < 4; ++m)
#pragma unroll
                for (int n = 0; n < 2; ++n) acc[a][b][m][n] = (f32x4){0.f, 0.f, 0.f, 0.f};
    bf16x8 At[4][2], B0[2][2], B1[2][2];
    unsigned vc[2][2]; int ridx[2][2];
#define PG8_RIDX(unit) do { _Pragma("unroll") for (int _h = 0; _h < 2; ++_h) _Pragma("unroll") for (int _i = 0; _i < 2; ++_i) ridx[_h][_i] = S.arow(unit, _h * HALF + RA[_i]); } while (0)
#define PG8_VC() do { _Pragma("unroll") for (int _h = 0; _h < 2; ++_h) _Pragma("unroll") for (int _i = 0; _i < 2; ++_i) vc[_h][_i] = (unsigned)ridx[_h][_i] * rowb + coffA[_i]; } while (0)
    PG8_RIDX(cur); PG8_VC();
    const char* cB = (const char*)g.Bt + (size_t)cur.pn * tstep;
    PG8_STAGE(PG8_SB(0, 0), cB, voffB); PG8_STAGE(PG8_SB(0, 1), cB + hstep, voffB); PG8_STAGE(PG8_SA(0, 0), gA, vc[0]); PG8_STAGE(PG8_SA(0, 1), gA, vc[1]);
    if (wr == 1) PG8_BAR;
    PG8_WAIT_V(2); PG8_BAR;
    PG8_STAGE(PG8_SB(1, 0), cB + kstep, voffB); PG8_STAGE(PG8_SA(1, 0), gA + kstep, vc[0]); PG8_STAGE(PG8_SB(1, 1), cB + hstep + kstep, voffB);
    PG8_WAIT_V(6); PG8_BAR;
    for (;;) {
        const bool has_next = S.next(ui + 1, nxt);
        const char* nB = has_next ? (const char*)g.Bt + (size_t)nxt.pn * tstep : cB;
        if (has_next) PG8_RIDX(nxt);
#pragma unroll 1
        for (int t = 0; t < nt; t += 2) {
            const bool last = (t == nt - 2);
            const char* a1 = gA + (size_t)(t + 1) * kstep;
            const char* a2 = last ? gA : gA + (size_t)(t + 2) * kstep; const char* b2 = last ? nB : cB + (size_t)(t + 2) * kstep;
            const char* a3 = a2 + kstep; const char* b3 = b2 + kstep;
            PG8_LDB(B0, 0, 0); PG8_LDB(B1, 0, 1); PG8_SCHED; PG8_LDA(At, 0, 0); PG8_STAGE(PG8_SA(1, 1), a1, vc[1]);
            if (last) PG8_VC();
            PG8_WAIT_V(8); PG8_WAIT_L(0); PG8_BAR; PG8_MMA(0, 0, At, B0); PG8_MMA(0, 1, At, B1); PG8_BAR; PG8_SCHED;
            PG8_LDA(At, 0, 1); PG8_STAGE(PG8_SB(0, 0), b2, voffB); PG8_STAGE(PG8_SB(0, 1), b2 + hstep, voffB); PG8_STAGE(PG8_SA(0, 0), a2, vc[0]);
            PG8_WAIT_V(8); PG8_WAIT_L(0); PG8_BAR; PG8_MMA(1, 0, At, B0); PG8_MMA(1, 1, At, B1); PG8_BAR; PG8_SCHED;
            PG8_LDB(B0, 1, 0); PG8_LDB(B1, 1, 1); PG8_SCHED; PG8_LDA(At, 1, 0); PG8_STAGE(PG8_SA(0, 1), a2, vc[1]);
            PG8_WAIT_V(8); PG8_WAIT_L(0); PG8_BAR; PG8_MMA(0, 0, At, B0); PG8_MMA(0, 1, At, B1); PG8_BAR; PG8_SCHED;
            PG8_LDA(At, 1, 1); PG8_STAGE(PG8_SB(1, 0), b3, voffB); PG8_STAGE(PG8_SB(1, 1), b3 + hstep, voffB); PG8_STAGE(PG8_SA(1, 0), a3, vc[0]);
            PG8_WAIT_V(8); PG8_WAIT_L(0); PG8_BAR; PG8_MMA(1, 0, At, B0); PG8_MMA(1, 1, At, B1); PG8_BAR; PG8_SCHED;
        }
        if constexpr (ALIGN_EPI) { if (wr == 0) PG8_BAR; }
        E(acc, cur, wr, wc, fr, fq);
        if (!has_next) break;
#pragma unroll
        for (int a = 0; a < 2; ++a)
#pragma unroll
            for (int b = 0; b < 2; ++b)
#pragma unroll
                for (int m = 0; m < 4; ++m)
#pragma unroll
                    for (int n = 0; n < 2; ++n) acc[a][b][m][n] = (f32x4){0.f, 0.f, 0.f, 0.f};
        cur = nxt; cB = nB; ++ui;
        if constexpr (ALIGN_EPI) { if (wr == 1) PG8_BAR; }
    }
    PG8_WAIT_V(0);
    if constexpr (!ALIGN_EPI) { if (wr == 0) PG8_BAR; }
    PG8_BAR;
#undef PG8_SA
#undef PG8_SB
#undef PG8_STAGE
#undef PG8_RIDX
#undef PG8_VC
#undef PG8_LDA
#undef PG8_LDB
#undef PG8_MMA
#undef PG8_WAIT_V
#undef PG8_WAIT_L
#undef PG8_BAR
#undef PG8_SCHED
}
}

constexpr int NWAVES = 8, NTHR = NWAVES * 64;
constexpr int BATCH = 16, SEQ = 2048, D = 2048, M = BATCH * SEQ;
constexpr int RW = 1024, RH = 64, RHEADS = 16, DEC_R = 64, AAA_R = 64, GATE_R = 160, LORA = DEC_R + AAA_R + GATE_R;
constexpr int RCOLS = 3 * RW + LORA;
constexpr int S5W = 1024, S5G = 16, S5NG = 64, S5P = 64;
constexpr int IN_COLS = RCOLS + S5W + 2 * D;
constexpr int NPROJ = 8704;
constexpr int PRW = 3584;
constexpr int NEXP = 32, DEXP = 512, CAP = 32768;
constexpr int MAXTILES = 288;
constexpr float RMS_EPS = 1e-6f, GN_EPS = 64e-5f;

constexpr size_t MiB = 1u << 20;
constexpr size_t WS_CTL = 0, CTL_ZERO_BYTES = 65536;
constexpr size_t WS_TOKI = 1 * MiB;
constexpr size_t WS_TOKW = 1 * MiB + 512 * 1024;
constexpr size_t WS_LIST = 2 * MiB;
constexpr size_t WS_WIN = 8 * MiB;
constexpr size_t WS_WINU8 = 20 * MiB;
constexpr size_t WS_WIN8 = 26 * MiB;
constexpr size_t WS_WGL = 42 * MiB;
constexpr size_t WS_WO = 50 * MiB;
constexpr size_t WS_WRO = 58 * MiB;
constexpr size_t WS_RT = 62 * MiB;
constexpr size_t WS_LORA = 63 * MiB;
constexpr size_t WS_MGU = 64 * MiB;
constexpr size_t WS_MD = 192 * MiB;
constexpr size_t WS_A = 256 * MiB;
constexpr size_t WS_B = 384 * MiB;
constexpr size_t WS_C = 672 * MiB;
constexpr size_t WS_LIN = 928 * MiB;
constexpr size_t WS_H28 = 947 * MiB;
constexpr size_t WS_END = 1011 * MiB;
constexpr size_t WS_H = WS_A, WS_YA = WS_A, WS_Z = WS_A + 64 * MiB;
constexpr size_t WS_PR = WS_B, WS_U = WS_B + 224 * MiB, WS_MIX = WS_B, WS_Y2 = WS_B;
constexpr size_t WS_YAO = WS_C, WS_YBO = WS_C + 128 * MiB;
constexpr size_t WS_HID = WS_C, WS_X1 = WS_C + 64 * MiB;
constexpr int CW_BAR = 4096;
constexpr int CW_CNT = 8192;

constexpr int LDSCTL_OFF = 0, MISC_OFF = 320, RING_OFF = 512, LDS_BYTES = 163840, RING_BYTES = LDS_BYTES - RING_OFF;

#define GAS __attribute__((address_space(1)))
#define LAS __attribute__((address_space(3)))
typedef unsigned short bf16;
typedef unsigned v4u __attribute__((ext_vector_type(4)));
typedef unsigned v2u __attribute__((ext_vector_type(2)));
typedef float f32x4 __attribute__((ext_vector_type(4)));
typedef float f32x16 __attribute__((ext_vector_type(16)));
typedef short bf16x8 __attribute__((ext_vector_type(8)));
#define LDS_WAIT() asm volatile("s_waitcnt lgkmcnt(0)" ::: "memory")
#define VM_WAIT() asm volatile("s_waitcnt vmcnt(0)" ::: "memory")
#define LDS_ORDER() asm volatile("" ::: "memory")
__device__ __forceinline__ unsigned f2bf(float f) { unsigned u = __builtin_bit_cast(unsigned, f); return (u + 0x7fffu + ((u >> 16) & 1u)) >> 16; }
__device__ __forceinline__ unsigned pk2(float lo, float hi) { return f2bf(lo) | (f2bf(hi) << 16); }
__device__ __forceinline__ float bflo(unsigned w) { return __builtin_bit_cast(float, w << 16); }
__device__ __forceinline__ float bfhi(unsigned w) { return __builtin_bit_cast(float, w & 0xffff0000u); }
__device__ __forceinline__ float bf2f(bf16 b) { return __builtin_bit_cast(float, ((unsigned)b) << 16); }
__device__ __forceinline__ float sigmoidf_(float x) { return __builtin_amdgcn_rcpf(1.0f + __expf(-x)); }
__device__ __forceinline__ float wave_sum(float v) {
#pragma unroll
    for (int o = 1; o < 64; o <<= 1) v += __shfl_xor(v, o);
    return v;
}

#define XB_TMO      128
#define XB_XCNT(j)  (256  + 64 * (j))
#define XB_XSUB(j)  (1280 + 64 * (j))
#define XB_XGEN(j)  (2304 + 64 * (j))
#define XB_TOP      3328
#define XB_TOPGEN   3392
#define XCD_BAR_WORDS 3456
#define XB_SPIN_CAP (1u << 18)

__device__ __forceinline__ unsigned xb_ld(unsigned* p)              { return __hip_atomic_load(p, __ATOMIC_RELAXED, __HIP_MEMORY_SCOPE_AGENT); }
__device__ __forceinline__ unsigned xb_add(unsigned* p, unsigned v) { return __hip_atomic_fetch_add(p, v, __ATOMIC_RELAXED, __HIP_MEMORY_SCOPE_AGENT); }
__device__ __forceinline__ unsigned xb_xcc_id() { return (unsigned)__builtin_amdgcn_s_getreg((3 << 11) | 20) & 0xFu; }
#define XB_SPIN(cond, bar) do { unsigned _sp = 0; while (cond) { __builtin_amdgcn_s_sleep(1); \
    if ((++_sp & 255u) == 0u) { if (xb_ld(&(bar)[XB_TMO])) break; if (_sp > XB_SPIN_CAP) { atomicAdd(&(bar)[XB_TMO], 1u); break; } } } } while (0)

struct XcdBarrier {
    unsigned* bar; unsigned x;
    volatile LAS unsigned* st;
};

__device__ __forceinline__ XcdBarrier xcd_barrier_post(unsigned* bar, volatile LAS unsigned* st) {
    XcdBarrier b; b.bar = bar; b.x = xb_xcc_id(); b.st = st;
    if (threadIdx.x == 0) (void)xb_add(&bar[XB_XCNT(b.x)], 1u);
    return b;
}
__device__ __forceinline__ void xcd_barrier_complete(unsigned* bar, unsigned x, unsigned& nloc, unsigned& nx) {
    const unsigned G = gridDim.x * gridDim.y * gridDim.z;
    unsigned sum, cnt, mine, sp = 0u;
    for (;;) {
        sum = 0u; cnt = 0u; mine = 0u;
#pragma unroll
        for (unsigned j = 0; j < 16; ++j) { const unsigned c = xb_ld(&bar[XB_XCNT(j)]); sum += c; cnt += (c > 0u) ? 1u : 0u; mine = (j == x) ? c : mine; }
        if (sum == G) break;
        __builtin_amdgcn_s_sleep(1);
        if ((++sp & 255u) == 0u) { if (xb_ld(&bar[XB_TMO])) break; if (sp > XB_SPIN_CAP) { atomicAdd(&bar[XB_TMO], 1u); break; } }
    }
    nloc = mine > 0u ? mine : 1u; nx = cnt > 0u ? cnt : 1u;
}

__device__ __forceinline__ void xcd_barrier(const XcdBarrier& b) {
    asm volatile("s_waitcnt vmcnt(0)" ::: "memory");
    __syncthreads();
    if (threadIdx.x == 0) {
        unsigned* bar = b.bar;
        __builtin_amdgcn_s_waitcnt(0);
        unsigned nloc = b.st[0], nx = b.st[1];
        if (nloc == 0u) { xcd_barrier_complete(bar, b.x, nloc, nx); b.st[0] = nloc; b.st[1] = nx; }
        const unsigned old = xb_add(&bar[XB_XSUB(b.x)], 1u);
        const unsigned gen = old / nloc;
        if (old + 1u == (gen + 1u) * nloc) {
            __builtin_amdgcn_fence(__ATOMIC_RELEASE, "agent");
            asm volatile("s_waitcnt vmcnt(0)" ::: "memory");
            const unsigned og = xb_add(&bar[XB_TOP], 1u);
            const unsigned tg = og / nx;
            if (og + 1u == (tg + 1u) * nx) xb_add(&bar[XB_TOPGEN], 1u);
            else XB_SPIN(xb_ld(&bar[XB_TOPGEN]) == tg, bar);
            __builtin_amdgcn_fence(__ATOMIC_ACQUIRE, "agent");
            xb_add(&bar[XB_XGEN(b.x)], 1u);
            asm volatile("s_waitcnt vmcnt(0)" ::: "memory");
        } else {
            XB_SPIN(xb_ld(&bar[XB_XGEN(b.x)]) == gen, bar);
            __builtin_amdgcn_fence(__ATOMIC_ACQUIRE, "agent");
            asm volatile("s_waitcnt vmcnt(0)" ::: "memory");
        }
    }
    __syncthreads();
}


constexpr int MOE_WGU_SH = 6, MOE_WD_SH = 5, MOE_HID_SH = 2, GLU_W_SH = 5, GLU_Z_SH = 2, Y2_SH = 4, WO_W_SH = 6, MIX_SH = 2;
__device__ __forceinline__ unsigned pk4_fp8(float a, float b, float c, float d) {
    a = __builtin_fminf(__builtin_fmaxf(a, -448.f), 448.f); b = __builtin_fminf(__builtin_fmaxf(b, -448.f), 448.f); c = __builtin_fminf(__builtin_fmaxf(c, -448.f), 448.f); d = __builtin_fminf(__builtin_fmaxf(d, -448.f), 448.f);
    int v = __builtin_amdgcn_cvt_pk_fp8_f32(a, b, 0, false); v = __builtin_amdgcn_cvt_pk_fp8_f32(c, d, v, true); return (unsigned)v; }

__device__ __forceinline__ void unpack8(const v4u w, float (&o)[8]) { o[0] = bflo(w.x); o[1] = bfhi(w.x); o[2] = bflo(w.y); o[3] = bfhi(w.y); o[4] = bflo(w.z); o[5] = bfhi(w.z); o[6] = bflo(w.w); o[7] = bfhi(w.w); }
__device__ __forceinline__ v4u pack8(const float (&o)[8]) { v4u w; w.x = pg8::cvt_pk_bf16(o[0], o[1]); w.y = pg8::cvt_pk_bf16(o[2], o[3]); w.z = pg8::cvt_pk_bf16(o[4], o[5]); w.w = pg8::cvt_pk_bf16(o[6], o[7]); return w; }
using pg8::Unit;
struct EpiProj {
    static constexpr bool PERM = true;
    bf16 *PR, *U; int pn0;
    __device__ __forceinline__ void operator()(const f32x4 (&acc)[2][2][4][2], const Unit& u, int wr, int wc, int fr, int fq) const {
        const int row0 = u.pm * 256 + wr * 64 + fr, pn = u.pn + pn0;
        const int kind = pn < 12 ? 0 : (pn < 14 ? 1 : 2);
        const int colt = kind == 0 ? pn * 256 : (kind == 1 ? (pn - 12) * 256 : (pn - 14) * 256);
#pragma unroll
        for (int ai = 0; ai < 2; ++ai)
#pragma unroll
            for (int m = 0; m < 4; ++m) { const int row = row0 + ai * 128 + m * 16, bb = row >> 11, tt = row & (SEQ - 1);
#pragma unroll
                for (int bj = 0; bj < 2; ++bj) { f32x4 v0 = acc[ai][bj][m][0], v1 = acc[ai][bj][m][1];
                    const int c = colt + bj * 128 + wc * 32 + 8 * fq; bf16* dst;
                    if (kind == 0) { const int a = c >> 10, hd = (c >> 6) & 15, cc = c & 63; dst = PR + ((((size_t)(bb * RHEADS + hd) * SEQ + tt) * 3 + a) * 64 + cc); }
                    else if (kind == 1) dst = PR + (size_t)M * (3 * RW) + (size_t)row * 512 + c;
                    else { const int gg = c >> 4, cc = c & 15; dst = U + (((size_t)(bb * S5NG + gg) * SEQ + tt) * 16 + cc); }
                    v4u w; w.x = pg8::cvt_pk_bf16(v0[0], v0[1]); w.y = pg8::cvt_pk_bf16(v0[2], v0[3]); w.z = pg8::cvt_pk_bf16(v1[0], v1[1]); w.w = pg8::cvt_pk_bf16(v1[2], v1[3]);
                    *(v4u*)dst = w; } }
    }
};
struct EpiYa {
    static constexpr bool PERM = true;
    bf16* O;
    __device__ __forceinline__ void operator()(const f32x4 (&acc)[2][2][4][2], const Unit& u, int wr, int wc, int fr, int fq) const {
        const int row0 = u.pm * 256 + wr * 64 + fr, col0 = u.pn * 256 + wc * 32 + 8 * fq;
#pragma unroll
        for (int ai = 0; ai < 2; ++ai)
#pragma unroll
            for (int m = 0; m < 4; ++m) { const size_t row = (size_t)(row0 + ai * 128 + m * 16);
#pragma unroll
                for (int bj = 0; bj < 2; ++bj) { const f32x4 v0 = acc[ai][bj][m][0], v1 = acc[ai][bj][m][1];
                    v4u w; w.x = pg8::cvt_pk_bf16(v0[0], v0[1]); w.y = pg8::cvt_pk_bf16(v0[2], v0[3]); w.z = pg8::cvt_pk_bf16(v1[0], v1[1]); w.w = pg8::cvt_pk_bf16(v1[2], v1[3]);
                    *(v4u*)(O + row * D + col0 + bj * 128) = w; } }
    }
};
struct EpiGlu {
    static constexpr bool PERM = true;
    bf16* O;
    __device__ __forceinline__ void operator()(const f32x4 (&acc)[2][2][4][2], const Unit& u, int wr, int wc, int fr, int fq) const {
        const int row0 = u.pm * 256 + wr * 64 + fr, col0 = u.pn * 128 + wc * 32 + 8 * fq;
#pragma unroll
        for (int ai = 0; ai < 2; ++ai)
#pragma unroll
            for (int m = 0; m < 4; ++m) { const size_t row = (size_t)(row0 + ai * 128 + m * 16);
                float o[8];
#pragma unroll
                for (int n = 0; n < 2; ++n)
#pragma unroll
                    for (int j = 0; j < 4; ++j) o[n * 4 + j] = acc[ai][0][m][n][j] * sigmoidf_(acc[ai][1][m][n][j]);
                *(v4u*)(O + row * D + col0) = pack8(o); }
    }
};
struct EpiMerge {
    static constexpr bool PERM = true;
    const bf16 *YA, *YB; unsigned char* MIX;
    __device__ __forceinline__ void operator()(const f32x4 (&acc)[2][2][4][2], const Unit& u, int wr, int wc, int fr, int fq) const {
        const int row0 = u.pm * 256 + wr * 64 + fr, col0 = u.pn * 128 + wc * 32 + 8 * fq;
#pragma unroll
        for (int ai = 0; ai < 2; ++ai)
#pragma unroll
            for (int m = 0; m < 4; ++m) { const size_t off = (size_t)(row0 + ai * 128 + m * 16) * D + col0;
                float a8[8], b8[8], o[8]; unpack8(*(const v4u*)(YA + off), a8); unpack8(*(const v4u*)(YB + off), b8);
#pragma unroll
                for (int n = 0; n < 2; ++n)
#pragma unroll
                    for (int j = 0; j < 4; ++j) o[n * 4 + j] = sigmoidf_(acc[ai][0][m][n][j]) * a8[n * 4 + j] + sigmoidf_(acc[ai][1][m][n][j]) * b8[n * 4 + j];
                constexpr float ms = (float)(1 << MIX_SH);
                *(v2u*)(MIX + off) = (v2u){pk4_fp8(o[0] * ms, o[1] * ms, o[2] * ms, o[3] * ms), pk4_fp8(o[4] * ms, o[5] * ms, o[6] * ms, o[7] * ms)}; }
    }
};
struct EpiX1 {
    static constexpr bool PERM = true;
    const float* X; bf16* O;
    __device__ __forceinline__ void operator()(const f32x4 (&acc)[2][2][4][2], const Unit& u, int wr, int wc, int fr, int fq) const {
        const int row0 = u.pm * 256 + wr * 64 + fr, col0 = u.pn * 256 + wc * 32 + 8 * fq;
#pragma unroll
        for (int ai = 0; ai < 2; ++ai) {
            f32x4 xv[4][2][2];
#pragma unroll
            for (int m = 0; m < 4; ++m) { const size_t off = (size_t)(row0 + ai * 128 + m * 16) * D + col0;
#pragma unroll
                for (int bj = 0; bj < 2; ++bj) { xv[m][bj][0] = *(const f32x4*)(X + off + bj * 128); xv[m][bj][1] = *(const f32x4*)(X + off + bj * 128 + 4); } }
#pragma unroll
            for (int m = 0; m < 4; ++m) { const size_t off = (size_t)(row0 + ai * 128 + m * 16) * D + col0;
#pragma unroll
                for (int bj = 0; bj < 2; ++bj) { const f32x4 v0 = xv[m][bj][0] + acc[ai][bj][m][0], v1 = xv[m][bj][1] + acc[ai][bj][m][1];
                    v4u w; w.x = pg8::cvt_pk_bf16(v0[0], v0[1]); w.y = pg8::cvt_pk_bf16(v0[2], v0[3]); w.z = pg8::cvt_pk_bf16(v1[0], v1[1]); w.w = pg8::cvt_pk_bf16(v1[2], v1[3]);
                    *(v4u*)(O + off + bj * 128) = w; } } }
    }
};
struct EpiMoeGU {
    static constexpr bool PERM = true;
    unsigned char* HID;
    __device__ __forceinline__ void operator()(const f32x4 (&acc)[2][2][4][2], const Unit& u, int wr, int wc, int fr, int fq) const {
        const int row0 = u.pm * 256 + wr * 64 + fr, col0 = (u.pn & 3) * 128 + wc * 32 + 8 * fq;
#pragma unroll
        for (int ai = 0; ai < 2; ++ai)
#pragma unroll
            for (int m = 0; m < 4; ++m) { float o[8];
#pragma unroll
                for (int n = 0; n < 2; ++n)
#pragma unroll
                    for (int j = 0; j < 4; ++j) { const float gt = acc[ai][0][m][n][j]; o[n * 4 + j] = gt * sigmoidf_(gt) * acc[ai][1][m][n][j] * (float)(1 << MOE_HID_SH); }
                v2u w; w.x = pk4_fp8(o[0], o[1], o[2], o[3]); w.y = pk4_fp8(o[4], o[5], o[6], o[7]);
                *(v2u*)(HID + (size_t)(row0 + ai * 128 + m * 16) * DEXP + col0) = w; }
    }
};
struct EpiMoeDown {
    static constexpr bool PERM = true;
    unsigned char* Y2;
    __device__ __forceinline__ void operator()(const f32x4 (&acc)[2][2][4][2], const Unit& u, int wr, int wc, int fr, int fq) const {
        const int row0 = u.pm * 256 + wr * 64 + fr, col0 = (u.pn & 7) * 256 + wc * 32 + 8 * fq; constexpr float ys = (float)(1 << Y2_SH);
#pragma unroll
        for (int ai = 0; ai < 2; ++ai)
#pragma unroll
            for (int m = 0; m < 4; ++m) { unsigned char* rowp = Y2 + (size_t)(row0 + ai * 128 + m * 16) * D + col0;
#pragma unroll
                for (int bj = 0; bj < 2; ++bj) { const f32x4 v0 = acc[ai][bj][m][0] * ys, v1 = acc[ai][bj][m][1] * ys;
                    v2u w; w.x = pk4_fp8(v0[0], v0[1], v0[2], v0[3]); w.y = pk4_fp8(v1[0], v1[1], v1[2], v1[3]);
                    *(v2u*)(rowp + bj * 128) = w; } }
    }
};
struct MoeOrder {
    const LAS int* tb; const LAS int* cntl; const int* list; int ncol, G, c; bool gather;
    __device__ __forceinline__ bool next(int i, Unit& u) const {
        const int L = i * G + c, total = tb[NEXP] * ncol; if (L >= total) return false;
        const int tr = L / ncol, j = L - tr * ncol; int e = 0;
        for (int k = 1; k < NEXP; ++k) e += (tb[k] <= tr) ? 1 : 0;
        u.pm = tr; u.pn = e * ncol + j; u.e = e; u.rt = tr - tb[e]; return true;
    }
    __device__ __forceinline__ int arow(const Unit& u, int r) const {
        if (!gather) return u.pm * 256 + r;
        const int pos = u.rt * 256 + r; return pos < cntl[u.e] ? list[(size_t)u.e * CAP + pos] : 0;
    }
};

struct Params { const float* in[35]; float* out; unsigned char* ws; int ph_lo, ph_hi; };
enum { I_X = 0, I_NMG, I_WIN, I_MU, I_W0, I_WUP, I_A0, I_AUP, I_GUP, I_KK, I_KA, I_RK, I_LNW, I_LNB, I_RWO, I_LRE, I_LIM, I_LSTEP, I_BRE, I_BIM, I_CRE, I_CIM, I_SD, I_GLV, I_GLG, I_WOUT, I_NFG,
       I_RGW, I_RGB, I_REW, I_REB, I_MG, I_MU2, I_MDN, I_NFIN };

struct CvtItem { const float* W; int N, k0, n0, dK, fp8; void* dst; size_t drow0; float scale; };
__device__ __forceinline__ void cvt_load(const CvtItem& d, float (&r)[32], int lane) {
#pragma unroll
    for (int i = 0; i < 32; ++i) r[i] = d.W[(size_t)(d.k0 + 2 * i + (lane >> 5)) * d.N + d.n0 + (lane & 31)];
}
__device__ __forceinline__ void cvt_store(const CvtItem& d, const float (&r)[32], LAS float* scr, int lane) {
#pragma unroll
    for (int i = 0; i < 32; ++i) scr[(2 * i + (lane >> 5)) * 33 + (lane & 31)] = r[i] * d.scale;
    LDS_ORDER();
    if (d.fp8) { const int c = lane & 3;
#pragma unroll
        for (int j = 0; j < 2; ++j) { const int n = (lane >> 2) + 16 * j; const LAS float* s = scr + (16 * c) * 33 + n;
            v4u o; o.x = pk4_fp8(s[0 * 33], s[1 * 33], s[2 * 33], s[3 * 33]); o.y = pk4_fp8(s[4 * 33], s[5 * 33], s[6 * 33], s[7 * 33]);
            o.z = pk4_fp8(s[8 * 33], s[9 * 33], s[10 * 33], s[11 * 33]); o.w = pk4_fp8(s[12 * 33], s[13 * 33], s[14 * 33], s[15 * 33]);
            *(v4u*)((unsigned char*)d.dst + (d.drow0 + n) * d.dK + d.k0 + 16 * c) = o; } }
    else { const int c = lane & 7;
#pragma unroll
        for (int j = 0; j < 4; ++j) { const int n = (lane >> 3) + 8 * j; const LAS float* s = scr + (8 * c) * 33 + n;
            v4u o; o.x = pk2(s[0 * 33], s[1 * 33]); o.y = pk2(s[2 * 33], s[3 * 33]); o.z = pk2(s[4 * 33], s[5 * 33]); o.w = pk2(s[6 * 33], s[7 * 33]);
            *(v4u*)((bf16*)d.dst + (d.drow0 + n) * d.dK + d.k0 + 8 * c) = o; } }
    LDS_ORDER();
}
template <class DescFn> __device__ __forceinline__ void cvt_run(const DescFn& desc, int it0, int nitems, int stride, LAS float* scr, int lane) {
    if (2 * it0 >= nitems) return;
    float ra[32], rb[32]; CvtItem da = desc(2 * it0), db = da; cvt_load(da, ra, lane);
    for (int g = it0; 2 * g < nitems; g += stride) {
        const int gn = g + stride;
        db = desc(2 * g + 1); cvt_load(db, rb, lane);
        cvt_store(da, ra, scr, lane);
        if (2 * gn < nitems) { da = desc(2 * gn); cvt_load(da, ra, lane); }
        cvt_store(db, rb, scr, lane);
    }
}
struct P2Desc { const Params* p;
    __device__ __forceinline__ CvtItem operator()(int it) const { constexpr int I5 = 32 * 512, I6 = 32 * 512, I7 = 32 * 512, I1 = 16 * 64, I2 = 16 * 64, I3 = 16 * 64, I4 = 32 * 64; unsigned char* ws = p->ws; int r = it;
        if (r < I5 + I6) { const int up = r >= I5 ? 1 : 0; if (up) r -= I5; const int e = r / 512, q = r % 512, kb = q / 16, nb = q % 16, n0 = nb * 32;
            return CvtItem{p->in[up ? I_MU2 : I_MG] + (size_t)e * D * DEXP, DEXP, kb * 64, n0, D, 1, ws + WS_MGU, (size_t)e * 1024 + (n0 >> 7) * 256 + up * 128 + (n0 & 127), (float)(1 << MOE_WGU_SH)}; } r -= I5 + I6;
        if (r < I7) { const int e = r / 512, q = r % 512, kb = q / 64, nb = q % 64;
            return CvtItem{p->in[I_MDN] + (size_t)e * DEXP * D, D, kb * 64, nb * 32, DEXP, 1, ws + WS_MD, (size_t)e * D + nb * 32, (float)(1 << MOE_WD_SH)}; } r -= I7;
        if (r < I1) { const int kb = r / 64, nb = r % 64; return CvtItem{p->in[I_RWO], D, kb * 64, nb * 32, RW, 0, ws + WS_WRO, (size_t)(nb * 32), 1.0f}; } r -= I1;
        if (r < I2) { const int kb = r / 64, nb = r % 64, n0 = nb * 32; return CvtItem{p->in[I_GLV], D, kb * 64, n0, S5W, 1, ws + WS_WGL, (size_t)((n0 >> 7) * 256 + (n0 & 127)), (float)(1 << GLU_W_SH)}; } r -= I2;
        if (r < I3) { const int kb = r / 64, nb = r % 64, n0 = nb * 32; return CvtItem{p->in[I_GLG], D, kb * 64, n0, S5W, 1, ws + WS_WGL, (size_t)((n0 >> 7) * 256 + 128 + (n0 & 127)), (float)(1 << GLU_W_SH)}; } r -= I3;
        if (r < I4) { const int kb = r / 64, nb = r % 64; return CvtItem{p->in[I_WOUT], D, kb * 64, nb * 32, D, 1, ws + WS_WO, (size_t)(nb * 32), (float)(1 << WO_W_SH)}; } r -= I4;
        return CvtItem{p->in[I_REW], 32, r * 64, 0, D, 0, ws + WS_RT, (size_t)4, 1.0f}; } };
constexpr int P2_ITEMS = 3 * 32 * 512 + 3 * 16 * 64 + 32 * 64 + 32;
__device__ __forceinline__ void p2_convert(const Params& p, LAS float* scr, int gw4, int NGW4, int lane) {
    P2Desc pd{&p}; cvt_run(pd, gw4, P2_ITEMS, NGW4, scr, lane);
    unsigned char* ws = p.ws; const size_t gt = (size_t)gw4 * 64 + lane, nth = (size_t)NGW4 * 64;
    v4u z; z.x = 0u; z.y = 0u; z.z = 0u; z.w = 0u;
    v4u* r0 = (v4u*)(ws + WS_RT + (size_t)36 * D * 2); for (size_t i = gt; i < (size_t)(256 - 36) * D / 8; i += nth) r0[i] = z;
    bf16* rt = (bf16*)(ws + WS_RT); for (size_t i = gt; i < (size_t)4 * D; i += nth) { const int n = (int)(i / D), k = (int)(i % D); rt[i] = (bf16)f2bf(p.in[I_RGW][k * 4 + n]); }
    bf16* wut = (bf16*)(ws + WS_LORA); bf16* aut = wut + RW * 64; bf16* gut = aut + RW * 64;
    for (size_t i = gt; i < (size_t)RW * 64; i += nth) { const int c = (int)(i >> 6), k = (int)(i & 63); wut[i] = (bf16)f2bf(p.in[I_WUP][(size_t)k * RW + c]); aut[i] = (bf16)f2bf(p.in[I_AUP][(size_t)k * RW + c]); }
    for (size_t i = gt; i < (size_t)RW * 160; i += nth) { const int c = (int)(i / 160), k = (int)(i % 160); gut[i] = (bf16)f2bf(p.in[I_GUP][(size_t)k * RW + c]); }
}
struct P0Desc { const Params* p;
    __device__ __forceinline__ CvtItem operator()(int it) const { unsigned char* ws = p->ws; const int kb = it / 265, nb = it % 265, n0 = nb * 32;
        if (n0 >= RCOLS + S5W) { const int gc = n0 - RCOLS - S5W, isb = gc >= D ? 1 : 0, c = gc - isb * D;
            return CvtItem{p->in[I_WIN], IN_COLS, kb * 64, n0, D, 1, ws + WS_WIN8, (size_t)((c >> 7) * 256 + isb * 128 + (c & 127)), (float)(1 << MOE_WGU_SH)}; }
        if (n0 >= RCOLS) return CvtItem{p->in[I_WIN], IN_COLS, kb * 64, n0, D, 1, ws + WS_WINU8, (size_t)(512 + n0 - RCOLS), (float)(1 << MOE_WGU_SH)};
        if (n0 >= 3 * RW) return CvtItem{p->in[I_WIN], IN_COLS, kb * 64, n0, D, 1, ws + WS_WINU8, (size_t)(n0 - 3 * RW), (float)(1 << MOE_WGU_SH)};
        return CvtItem{p->in[I_WIN], IN_COLS, kb * 64, n0, D, 0, ws + WS_WIN, (size_t)n0, 1.0f}; } };
__device__ __forceinline__ void p0_prologue(const Params& p, LAS unsigned char* lds, int gw, int NGW, int wave, int lane) {
    LAS float* scr = (LAS float*)(lds + wave * 16384);
    unsigned char* ws = p.ws;
    { P0Desc pd{&p}; cvt_run(pd, gw, 32 * 265, NGW, scr, lane); }
    { const size_t gt = (size_t)gw * 64 + lane, nth = (size_t)NGW * 64;
      v4u z; z.x = 0u; z.y = 0u; z.z = 0u; z.w = 0u;
      v4u* w0 = (v4u*)(ws + WS_WINU8 + (size_t)LORA * D); for (size_t i = gt; i < (size_t)(512 - LORA) * D / 16; i += nth) w0[i] = z; }
    bf16* H = (bf16*)(ws + WS_H);
    {
        f32x4 g[8], v[8], vn[8];
#pragma unroll
        for (int j = 0; j < 8; ++j) g[j] = ((const f32x4*)p.in[I_NMG] + lane)[64 * j];
        if (gw < M) {
#pragma unroll
            for (int j = 0; j < 8; ++j) v[j] = ((const f32x4*)(p.in[I_X] + (size_t)gw * D) + lane)[64 * j]; }
        for (int m = gw; m < M; m += NGW) {
            const int mn = m + NGW < M ? m + NGW : m;
#pragma unroll
            for (int j = 0; j < 8; ++j) vn[j] = ((const f32x4*)(p.in[I_X] + (size_t)mn * D) + lane)[64 * j];
            float s = 0.f;
#pragma unroll
            for (int j = 0; j < 8; ++j) s += (v[j].x * v[j].x + v[j].y * v[j].y) + (v[j].z * v[j].z + v[j].w * v[j].w);
            const float rs = 1.0f / sqrtf(wave_sum(s) * (1.f / D) + RMS_EPS);
            v2u* o8 = (v2u*)(H + (size_t)m * D) + lane; unsigned* o4 = (unsigned*)(ws + WS_H28 + (size_t)m * D) + lane;
#pragma unroll
            for (int j = 0; j < 8; ++j) { const f32x4 y = v[j] * rs * g[j]; v2u w; w.x = pk2(y.x, y.y); w.y = pk2(y.z, y.w); o8[64 * j] = w; o4[64 * j] = pk4_fp8(y.x, y.y, y.z, y.w); }
#pragma unroll
            for (int j = 0; j < 8; ++j) v[j] = vn[j];
        }
    }
}

typedef short s16x4 __attribute__((ext_vector_type(4)));
constexpr int CP = 68;
constexpr int SL_AT = 0, SL_RT = 16 * CP * 2, SL_BT = 2 * SL_RT, SL_KT = 3 * SL_RT, SL_VT = 4 * SL_RT;
constexpr int SL_GAK = 5 * SL_RT, SL_GRK = SL_GAK + 512, SL_TT = SL_GRK + 512, SL_GT = SL_TT + 512, SL_PL = SL_GT + 512, SLOT_BYTES = SL_PL + 256;
constexpr int YB_OFF = 8 * SLOT_BYTES, YB_CHUNK = 16 * 64 * 2;
constexpr int PRM_OFF = YB_OFF + 8 * YB_CHUNK;
constexpr int LW_OFF = PRM_OFF + 10 * 64 * 4;
constexpr int BON_OFF = LW_OFF + 36 * 1024;
static_assert(BON_OFF + 8 * 64 <= RING_BYTES, "rwkv LDS");
template <int CTRL> __device__ __forceinline__ float dpp_mov0(float v) { return __builtin_bit_cast(float, __builtin_amdgcn_update_dpp(0, __builtin_bit_cast(int, v), CTRL, 0xf, 0xf, false)); }
template <int CTRL> __device__ __forceinline__ float dpp_mov1(float v) { return __builtin_bit_cast(float, __builtin_amdgcn_update_dpp(0x3f800000, __builtin_bit_cast(int, v), CTRL, 0xf, 0xf, false)); }
__device__ __forceinline__ float row_scanmul16(float v) { v *= dpp_mov1<0x111>(v); v *= dpp_mov1<0x112>(v); v *= dpp_mov1<0x114>(v); v *= dpp_mov1<0x118>(v); return v; }
__device__ __forceinline__ float row_scan16(float v) { v += dpp_mov0<0x111>(v); v += dpp_mov0<0x112>(v); v += dpp_mov0<0x114>(v); v += dpp_mov0<0x118>(v); return v; }
__device__ __forceinline__ s16x4 pack4(const f32x4 v) { v2u w; w.x = pg8::cvt_pk_bf16(v[0], v[1]); w.y = pg8::cvt_pk_bf16(v[2], v[3]); return __builtin_bit_cast(s16x4, w); }
__device__ __forceinline__ f32x4 mm16(const f32x4 aT, const f32x4 b) { return __builtin_amdgcn_mfma_f32_16x16x16bf16_1k(pack4(aT), pack4(b), (f32x4){0.f, 0.f, 0.f, 0.f}, 0, 0, 0); }
__device__ __forceinline__ bf16x8 cat8(const s16x4 a, const s16x4 b) { return (bf16x8){a[0], a[1], a[2], a[3], b[0], b[1], b[2], b[3]}; }
__device__ __forceinline__ float tanh_fast(float x) { return 1.0f - 2.0f * __builtin_amdgcn_rcpf(1.0f + __expf(2.0f * x)); }
__device__ __forceinline__ void st16(LAS unsigned char* a, const v4u w) { *(LAS v2u*)a = (v2u){w.x, w.y}; *(LAS v2u*)(a + 8) = (v2u){w.z, w.w}; }


__device__ __forceinline__ void rwkv_stage(const Params& p, int h, LAS unsigned char* lds, int tid) {
    LAS float* PRM = (LAS float*)(lds + PRM_OFF);
    for (int i = tid; i < 640; i += NTHR) { const int idx = i >> 6, c = h * 64 + (i & 63); float v;
        switch (idx) { case 0: v = p.in[I_W0][c]; break; case 1: v = p.in[I_A0][c]; break; case 2: v = p.in[I_KK][c]; break; case 3: v = p.in[I_KA][c]; break; case 4: v = p.in[I_RK][c]; break;
                       case 5: v = p.in[I_LNW][c]; break; case 6: v = p.in[I_LNB][c]; break; default: v = p.in[I_MU][(idx - 7) * RW + c]; break; }
        PRM[i] = v; }
    const bf16* WUT = (const bf16*)(p.ws + WS_LORA); const bf16* AUT = WUT + RW * 64; const bf16* GUT = AUT + RW * 64;
    for (int i = tid; i < 36 * 64; i += NTHR) { const int f = i >> 6, l = i & 63, m = l & 15, kq = l >> 4; const bf16* src; int nt, ks;
        if (f < 8) { nt = f >> 1; ks = f & 1; src = WUT + (size_t)(h * 64 + 16 * (m >> 2) + 4 * nt + (m & 3)) * 64 + 32 * ks + 8 * kq; }
        else if (f < 16) { nt = (f - 8) >> 1; ks = f & 1; src = AUT + (size_t)(h * 64 + 16 * (m >> 2) + 4 * nt + (m & 3)) * 64 + 32 * ks + 8 * kq; }
        else { nt = (f - 16) / 5; ks = (f - 16) - 5 * nt; src = GUT + (size_t)(h * 64 + 16 * (m >> 2) + 4 * nt + (m & 3)) * 160 + 32 * ks + 8 * kq; }
        *(LAS v4u*)(lds + LW_OFF + i * 16) = *(const v4u*)src; }
    __syncthreads();
}
struct RwkvPre { bf16x8 bx[9]; };
template <int K0, int K1> __device__ __forceinline__ void rwkv_load(const Params& p, int b, int h, int ch, RwkvPre& pre, int lane) {
    const int t = lane & 15, q = lane >> 4;
    const bf16* LIN = (const bf16*)(p.ws + WS_LIN);
    const size_t row = (size_t)b * SEQ + ch * 16 + t;
#pragma unroll
    for (int ks = K0; ks < K1; ++ks) pre.bx[ks] = *(const bf16x8*)(LIN + row * LORA + 32 * ks + 8 * q);
}
__device__ __forceinline__ void rwkv_prep(const Params& p, int b, int h, int ch, LAS unsigned char* lds, LAS unsigned char* slot, LAS float* bonp, const RwkvPre& pre, int lane) {
    const int t = lane & 15, q = lane >> 4;
    int zo = 0; asm volatile("" : "+v"(zo));
    const LAS unsigned char* LW = lds + LW_OFF + zo + lane * 16; const LAS float* PRM = (const LAS float*)(lds + PRM_OFF + zo) + 16 * q;
    v4u cu[3][2], pu[3][2];
    { const bf16* prow = (const bf16*)(p.ws + WS_PR) + (((size_t)(b * RHEADS + h) * SEQ + ch * 16 + t) * 3) * 64 + 16 * q; const bool hasp = (ch * 16 + t) > 0; const bf16* pprev = hasp ? prow - 192 : prow;
#pragma unroll
      for (int a = 0; a < 3; ++a)
#pragma unroll
        for (int hf = 0; hf < 2; ++hf) { cu[a][hf] = *(const v4u*)(prow + a * 64 + 8 * hf); pu[a][hf] = *(const v4u*)(pprev + a * 64 + 8 * hf); }
      if (ch == 0) {
#pragma unroll
        for (int a = 0; a < 3; ++a)
#pragma unroll
          for (int hf = 0; hf < 2; ++hf) if (!hasp) pu[a][hf] = (v4u){0u, 0u, 0u, 0u}; } }
    const f32x4 z4 = (f32x4){0.f, 0.f, 0.f, 0.f};
    float lp[16];
    {
        f32x4 wacc[4] = {z4, z4, z4, z4};
#pragma unroll
        for (int ks = 0; ks < 2; ++ks)
            {
#pragma unroll
                for (int nt = 0; nt < 4; ++nt) wacc[nt] = __builtin_amdgcn_mfma_f32_16x16x32_bf16(*(const LAS bf16x8*)(LW + (nt * 2 + ks) * 1024), pre.bx[ks], wacc[nt], 0, 0, 0); __builtin_amdgcn_sched_barrier(0); }
#pragma unroll
        for (int nt = 0; nt < 4; ++nt) { const f32x4 w0 = *(const LAS f32x4*)(PRM + 0 * 64 + 4 * nt);
#pragma unroll
            for (int rr = 0; rr < 4; ++rr) lp[4 * nt + rr] = row_scanmul16(__builtin_amdgcn_exp2f(-0.8750387749f * sigmoidf_(w0[rr] + wacc[nt][rr]))); }
    }
    if (t == 15) {
#pragma unroll
        for (int nt = 0; nt < 4; ++nt) *(LAS f32x4*)(slot + SL_PL + (16 * q + 4 * nt) * 4) = (f32x4){lp[4 * nt], lp[4 * nt + 1], lp[4 * nt + 2], lp[4 * nt + 3]}; }
    float asg[16];
    {
        f32x4 aacc[4] = {z4, z4, z4, z4};
#pragma unroll
        for (int ks = 0; ks < 2; ++ks)
            {
#pragma unroll
                for (int nt = 0; nt < 4; ++nt) aacc[nt] = __builtin_amdgcn_mfma_f32_16x16x32_bf16(*(const LAS bf16x8*)(LW + (8 + nt * 2 + ks) * 1024), pre.bx[2 + ks], aacc[nt], 0, 0, 0); __builtin_amdgcn_sched_barrier(0); }
#pragma unroll
        for (int nt = 0; nt < 4; ++nt) { const f32x4 a0 = *(const LAS f32x4*)(PRM + 1 * 64 + 4 * nt);
#pragma unroll
            for (int rr = 0; rr < 4; ++rr) asg[4 * nt + rr] = sigmoidf_(a0[rr] + aacc[nt][rr]); }
    }
#define RW_SHIFT8(dst, a_) { const f32x4 m0 = *(const LAS f32x4*)(PRM + (7 + (a_)) * 64 + 8 * hf), m1 = *(const LAS f32x4*)(PRM + (7 + (a_)) * 64 + 8 * hf + 4); float a8[8], b8[8]; unpack8(cu[a_][hf], a8); unpack8(pu[a_][hf], b8); \
        _Pragma("unroll") for (int j = 0; j < 8; ++j) dst[j] = a8[j] + (b8[j] - a8[j]) * (j < 4 ? m0[j] : m1[j - 4]); }
#pragma unroll
    for (int hf = 0; hf < 2; ++hf) { float v8[8]; RW_SHIFT8(v8, 2) st16(slot + SL_VT + (t * CP + 16 * q + 8 * hf) * 2, pack8(v8)); }
    unsigned kkp[8]; float ss = 0.f, bon = 0.f;
    bf16x8 fa[2], fb[2], fk[2], fr[2];
#pragma unroll
    for (int hf = 0; hf < 2; ++hf) { float k8[8], r8[8], o[8]; RW_SHIFT8(k8, 1) RW_SHIFT8(r8, 0)
        const f32x4 kk0 = *(const LAS f32x4*)(PRM + 2 * 64 + 8 * hf), kk1 = *(const LAS f32x4*)(PRM + 2 * 64 + 8 * hf + 4), ka0 = *(const LAS f32x4*)(PRM + 3 * 64 + 8 * hf), ka1 = *(const LAS f32x4*)(PRM + 3 * 64 + 8 * hf + 4);
        const f32x4 rk0 = *(const LAS f32x4*)(PRM + 4 * 64 + 8 * hf), rk1 = *(const LAS f32x4*)(PRM + 4 * 64 + 8 * hf + 4);
        float kprev = 0.f;
#pragma unroll
        for (int j = 0; j < 8; ++j) { const int e = 8 * hf + j; const float kkc = j < 4 ? kk0[j] : kk1[j - 4], kac = j < 4 ? ka0[j] : ka1[j - 4], rkc = j < 4 ? rk0[j] : rk1[j - 4];
            const float kv = k8[j] * kkc; ss += kv * kv; if (j & 1) kkp[e >> 1] = pg8::cvt_pk_bf16(kprev, kv); kprev = kv;
            const float k2v = k8[j] * (1.0f + (asg[e] - 1.0f) * kac); bon += r8[j] * k2v * rkc;
            const float e1 = lp[e]; o[j] = k2v * __builtin_amdgcn_rcpf(e1); r8[j] = r8[j] * e1; }
        v4u w = pack8(o); fk[hf] = __builtin_bit_cast(bf16x8, w); st16(slot + SL_KT + (t * CP + 16 * q + 8 * hf) * 2, w);
        w = pack8(r8); fr[hf] = __builtin_bit_cast(bf16x8, w); st16(slot + SL_RT + (t * CP + 16 * q + 8 * hf) * 2, w); }
#undef RW_SHIFT8
    ss += __shfl_xor(ss, 16); ss += __shfl_xor(ss, 32); bon += __shfl_xor(bon, 16); bon += __shfl_xor(bon, 32);
    if (q == 0) bonp[t] = bon;
    const float inv = 1.0f / fmaxf(sqrtf(ss), 1e-12f);
#pragma unroll
    for (int hf = 0; hf < 2; ++hf) { float oa[8], ob[8];
#pragma unroll
        for (int j = 0; j < 8; ++j) { const int e = 8 * hf + j; const float kn = ((e & 1) ? bfhi(kkp[e >> 1]) : bflo(kkp[e >> 1])) * inv; oa[j] = -kn * dpp_mov1<0x111>(lp[e]); ob[j] = kn * asg[e] * __builtin_amdgcn_rcpf(lp[e]); }
        v4u w = pack8(oa); fa[hf] = __builtin_bit_cast(bf16x8, w); st16(slot + SL_AT + (t * CP + 16 * q + 8 * hf) * 2, w);
        w = pack8(ob); fb[hf] = __builtin_bit_cast(bf16x8, w); st16(slot + SL_BT + (t * CP + 16 * q + 8 * hf) * 2, w); }
    f32x4 G = z4, GT_ = z4, GakT = z4, GrkT = z4, GrbT = z4;
#pragma unroll
    for (int hf = 0; hf < 2; ++hf) {
        G = __builtin_amdgcn_mfma_f32_16x16x32_bf16(fa[hf], fb[hf], G, 0, 0, 0);
        GT_ = __builtin_amdgcn_mfma_f32_16x16x32_bf16(fb[hf], fa[hf], GT_, 0, 0, 0);
        GakT = __builtin_amdgcn_mfma_f32_16x16x32_bf16(fk[hf], fa[hf], GakT, 0, 0, 0);
        GrkT = __builtin_amdgcn_mfma_f32_16x16x32_bf16(fk[hf], fr[hf], GrkT, 0, 0, 0);
        GrbT = __builtin_amdgcn_mfma_f32_16x16x32_bf16(fb[hf], fr[hf], GrbT, 0, 0, 0);
    }
    f32x4 I4;
#pragma unroll
    for (int rr = 0; rr < 4; ++rr) { const int rw = 4 * q + rr;
        I4[rr] = (rw == t) ? 1.0f : 0.0f;
        G[rr] = (rw > t) ? G[rr] : 0.f;
        GT_[rr] = (t > rw) ? GT_[rr] : 0.f;
        GakT[rr] = (t > rw) ? GakT[rr] : 0.f;
        GrkT[rr] = (t >= rw) ? GrkT[rr] : 0.f;
        GrbT[rr] = (t >= rw) ? GrbT[rr] : 0.f; }
    const f32x4 G2 = mm16(GT_, G), G2T = mm16(G, GT_);
    const f32x4 G4 = mm16(G2T, G2), G4T = mm16(G2, G2T);
    const f32x4 G8 = mm16(G4T, G4), G8T = mm16(G4, G4T);
    const f32x4 P1 = mm16(I4 + GT_, I4 + G2), P1T = mm16(I4 + G2, I4 + GT_);
    const f32x4 P2 = mm16(P1T, I4 + G4), P2T = mm16(I4 + G4, P1T);
    const f32x4 Tt = mm16(P2T, I4 + G8), TtT = mm16(I4 + G8, P2T);
    (void)G8T; (void)P2;
    const f32x4 GTmT = mm16(Tt, GrbT);
    *(LAS s16x4*)(slot + SL_GAK + t * 32 + q * 8) = pack4(GakT);
    *(LAS s16x4*)(slot + SL_GRK + t * 32 + q * 8) = pack4(GrkT);
    *(LAS s16x4*)(slot + SL_TT + t * 32 + q * 8) = pack4(TtT);
    *(LAS s16x4*)(slot + SL_GT + t * 32 + q * 8) = pack4(GTmT);
}
__device__ __forceinline__ void rwkv_post(const Params& p, int b, int h, int ch, const LAS unsigned char* lds, float bon, const LAS unsigned char* yb, const v4u (&vk)[2], const RwkvPre& pre, int lane) {
    const int t = lane & 15, q = lane >> 4, hc = h * 64 + 16 * q;
    bf16* YA = (bf16*)(p.ws + WS_YA);
    int zo = 0; asm volatile("" : "+v"(zo));
    const LAS unsigned char* LW = lds + LW_OFF + zo + lane * 16;
    const LAS float* pLW = (const LAS float*)(lds + PRM_OFF + zo) + 5 * 64 + 16 * q; const LAS float* pLB = pLW + 64;
    const f32x4 z4 = (f32x4){0.f, 0.f, 0.f, 0.f};
    f32x4 gacc[4] = {z4, z4, z4, z4};
#pragma unroll
    for (int ks = 0; ks < 5; ++ks)
        {
#pragma unroll
            for (int nt = 0; nt < 4; ++nt) gacc[nt] = __builtin_amdgcn_mfma_f32_16x16x32_bf16(*(const LAS bf16x8*)(LW + (16 + nt * 5 + ks) * 1024), pre.bx[4 + ks], gacc[nt], 0, 0, 0); __builtin_amdgcn_sched_barrier(0); }
    float y[16], v[16];
#pragma unroll
    for (int hf = 0; hf < 2; ++hf) { float o[8]; unpack8(*(const LAS v4u*)(yb + (t * 64 + 16 * q + 8 * hf) * 2), o);
#pragma unroll
        for (int j = 0; j < 8; ++j) y[8 * hf + j] = o[j];
        unpack8(vk[hf], o);
#pragma unroll
        for (int j = 0; j < 8; ++j) v[8 * hf + j] = o[j]; }
    float s = 0.f;
#pragma unroll
    for (int e = 0; e < 16; ++e) s += y[e];
    s += __shfl_xor(s, 16); s += __shfl_xor(s, 32);
    const float mean = s * (1.f / 64.f); float s2 = 0.f;
#pragma unroll
    for (int e = 0; e < 16; ++e) { y[e] -= mean; s2 += y[e] * y[e]; }
    s2 += __shfl_xor(s2, 16); s2 += __shfl_xor(s2, 32);
    const float rstd = 1.0f / sqrtf(s2 * (1.f / 64.f) + GN_EPS);
    const size_t row = (size_t)b * SEQ + ch * 16 + t;
#pragma unroll
    for (int hf = 0; hf < 2; ++hf) { float o[8];
#pragma unroll
        for (int j = 0; j < 8; ++j) { const int e = 8 * hf + j; o[j] = (y[e] * rstd * pLW[e] + pLB[e] + bon * v[e]) * gacc[2 * hf + (j >> 2)][j & 3]; }
        *(v4u*)(YA + row * RW + hc + 8 * hf) = pack8(o); }
}
__device__ __forceinline__ void rwkv_step(const LAS unsigned char* slot, LAS unsigned char* yb, f32x4 (&X)[4], int i0, int lane) {
    const int li = lane & 15, q = lane >> 4;
    const f32x4 z4 = (f32x4){0.f, 0.f, 0.f, 0.f};
    const bf16x8 xb0 = cat8(pack4(X[0]), pack4(X[1])), xb1 = cat8(pack4(X[2]), pack4(X[3]));
    const LAS unsigned char* arow = slot + SL_AT + li * CP * 2 + q * 8; const LAS unsigned char* rrow = slot + SL_RT + li * CP * 2 + q * 8;
    const bf16x8 a0 = cat8(*(const LAS s16x4*)(arow), *(const LAS s16x4*)(arow + 32)), a1 = cat8(*(const LAS s16x4*)(arow + 64), *(const LAS s16x4*)(arow + 96));
    const bf16x8 r0 = cat8(*(const LAS s16x4*)(rrow), *(const LAS s16x4*)(rrow + 32)), r1 = cat8(*(const LAS s16x4*)(rrow + 64), *(const LAS s16x4*)(rrow + 96));
    const unsigned troff = (unsigned)((4 * q + (li >> 2)) * CP * 2 + (li & 3) * 8);
    const s16x4 vb = __builtin_amdgcn_ds_read_tr16_b64_v4i16((LAS s16x4*)(slot + SL_VT + troff + i0 * 2));
    const s16x4 gak = *(const LAS s16x4*)(slot + SL_GAK + li * 32 + q * 8), grk = *(const LAS s16x4*)(slot + SL_GRK + li * 32 + q * 8);
    const s16x4 tt = *(const LAS s16x4*)(slot + SL_TT + li * 32 + q * 8), gt = *(const LAS s16x4*)(slot + SL_GT + li * 32 + q * 8);
    s16x4 bT[4], kT[4]; f32x4 pl[4];
#pragma unroll
    for (int jt = 0; jt < 4; ++jt) { bT[jt] = __builtin_amdgcn_ds_read_tr16_b64_v4i16((LAS s16x4*)(slot + SL_BT + troff + jt * 32)); kT[jt] = __builtin_amdgcn_ds_read_tr16_b64_v4i16((LAS s16x4*)(slot + SL_KT + troff + jt * 32));
        pl[jt] = *(const LAS f32x4*)(slot + SL_PL + (16 * jt + 4 * q) * 4); }
    LDS_WAIT();
    f32x4 PA = __builtin_amdgcn_mfma_f32_16x16x32_bf16(a0, xb0, z4, 0, 0, 0); PA = __builtin_amdgcn_mfma_f32_16x16x32_bf16(a1, xb1, PA, 0, 0, 0);
    f32x4 PRr = __builtin_amdgcn_mfma_f32_16x16x32_bf16(r0, xb0, z4, 0, 0, 0); PRr = __builtin_amdgcn_mfma_f32_16x16x32_bf16(r1, xb1, PRr, 0, 0, 0);
    PA = __builtin_amdgcn_mfma_f32_16x16x16bf16_1k(gak, vb, PA, 0, 0, 0);
    PRr = __builtin_amdgcn_mfma_f32_16x16x16bf16_1k(grk, vb, PRr, 0, 0, 0);
    const s16x4 pa4 = pack4(PA);
    const f32x4 SA = __builtin_amdgcn_mfma_f32_16x16x16bf16_1k(tt, pa4, z4, 0, 0, 0);
    const f32x4 Y = __builtin_amdgcn_mfma_f32_16x16x16bf16_1k(gt, pa4, PRr, 0, 0, 0);
    const bf16x8 sb = cat8(pack4(SA), vb);
#pragma unroll
    for (int jt = 0; jt < 4; ++jt) {
        X[jt] = __builtin_amdgcn_mfma_f32_16x16x32_bf16(cat8(bT[jt], kT[jt]), sb, X[jt], 0, 0, 0);
        X[jt] = X[jt] * pl[jt]; }
    { const unsigned y01 = pg8::cvt_pk_bf16(Y[0], Y[1]), y23 = pg8::cvt_pk_bf16(Y[2], Y[3]);
      *(LAS bf16*)(yb + ((4 * q + 0) * 64 + i0 + li) * 2) = (bf16)(y01 & 0xffffu); *(LAS bf16*)(yb + ((4 * q + 1) * 64 + i0 + li) * 2) = (bf16)(y01 >> 16);
      *(LAS bf16*)(yb + ((4 * q + 2) * 64 + i0 + li) * 2) = (bf16)(y23 & 0xffffu); *(LAS bf16*)(yb + ((4 * q + 3) * 64 + i0 + li) * 2) = (bf16)(y23 >> 16); }
}
__device__ __forceinline__ void rwkv_slot(const Params& p, int b, int h, int s, int NS, LAS unsigned char* lds, v4u (&vk)[2], float& bk, RwkvPre& pre, f32x4 (&X)[4], int wave, int lane) {
    const int j = wave & 3;
    if (wave >= 4) {
        if (s < NS) { rwkv_prep(p, b, h, 4 * s + j, lds, lds + ((s & 1) * 4 + j) * SLOT_BYTES, (LAS float*)(lds + BON_OFF) + ((s & 1) * 4 + j) * 16, pre, lane);
            if (s + 1 < NS) rwkv_load<0, 4>(p, b, h, 4 * (s + 1) + j, pre, lane); }
    } else {
        if (s >= 1 && s <= NS) {
            const int bank = ((s - 1) & 1) * 4;
#pragma unroll 1
            for (int cc = 0; cc < 4; ++cc) rwkv_step(lds + (bank + cc) * SLOT_BYTES, lds + YB_OFF + (bank + cc) * YB_CHUNK, X, 16 * wave, lane);
        }
        if (s >= 2) { rwkv_post(p, b, h, 4 * (s - 2) + j, lds, bk, lds + YB_OFF + ((s & 1) * 4 + j) * YB_CHUNK, vk, pre, lane);
            if (s - 1 < NS) rwkv_load<4, 9>(p, b, h, 4 * (s - 1) + j, pre, lane); }
        if (s >= 1 && s <= NS) { const int t = lane & 15, q = lane >> 4; const LAS unsigned char* va = lds + (((s - 1) & 1) * 4 + j) * SLOT_BYTES + SL_VT + (t * CP + 16 * q) * 2;
#pragma unroll
            for (int hf = 0; hf < 2; ++hf) { const v2u v0 = *(const LAS v2u*)(va + 16 * hf), v1 = *(const LAS v2u*)(va + 16 * hf + 8); vk[hf] = (v4u){v0.x, v0.y, v1.x, v1.y}; }
            bk = ((const LAS float*)(lds + BON_OFF))[(((s - 1) & 1) * 4 + j) * 16 + t]; }
    }
    LDS_WAIT(); __builtin_amdgcn_s_barrier(); asm volatile("" ::: "memory");
}
__device__ __forceinline__ void rwkv_unit_c(const Params& p, int unit, LAS unsigned char* lds, int wave, int lane) {
    const int b = unit >> 4, h = unit & 15;
    f32x4 X[4];
#pragma unroll
    for (int jt = 0; jt < 4; ++jt) X[jt] = (f32x4){0.f, 0.f, 0.f, 0.f};
    v4u vk[2]; vk[0] = vk[1] = (v4u){0u, 0u, 0u, 0u}; float bk = 0.f;
    rwkv_stage(p, h, lds, threadIdx.x);
    constexpr int NS = SEQ / 64;
    RwkvPre pre; rwkv_load<0, 9>(p, b, h, wave & 3, pre, lane);
    for (int s = 0; s <= NS + 1; ++s) rwkv_slot(p, b, h, s, NS, lds, vk, bk, pre, X, wave, lane);
    __syncthreads();
}
__device__ __forceinline__ void sincos_acc(float x, float& s, float& c) {
    const float n = rintf(x * 0.636619772367581343f);
    float r = fmaf(n, -1.5707962513e+00f, x); r = fmaf(n, -7.5497894159e-08f, r); r = fmaf(n, -5.3903029534e-15f, r);
    const float r2 = r * r;
    float sp = fmaf(r2, 2.86567956e-6f, -1.98559923e-4f); sp = fmaf(sp, r2, 8.33338592e-3f); sp = fmaf(sp, r2, -1.66666672e-1f); sp = fmaf(sp * r2, r, r);
    float cp = fmaf(r2, 2.44677067e-5f, -1.38877297e-3f); cp = fmaf(cp, r2, 4.16666567e-2f); cp = fmaf(cp, r2, -0.5f); cp = fmaf(cp, r2, 1.0f);
    const int q = ((int)n) & 3;
    const float ss = (q & 1) ? cp : sp, cc = (q & 1) ? sp : cp;
    s = (q & 2) ? -ss : ss; c = ((q + 1) & 2) ? -cc : cc;
}
__device__ __forceinline__ float gelu_tanh(float y) { const float a = 0.7978845608028654f * (y + 0.044715f * y * y * y); const float t = 1.0f - 2.0f * __builtin_amdgcn_rcpf(1.0f + __expf(2.0f * a)); return 0.5f * y * (1.0f + t); }
constexpr int S5_BU_PITCH = 132, S5_XS_PITCH = 136, S5_WAVE_LDS = 32 * S5_BU_PITCH * 4 + 32 * S5_XS_PITCH * 2;
__device__ __forceinline__ void s5_unit(const Params& p, int unit, LAS unsigned char* wl, int lane) {
    const int b = unit >> 6, g = unit & 63;
    LAS float* BU = (LAS float*)wl; LAS bf16* XS = (LAS bf16*)(wl + 32 * S5_BU_PITCH * 4);
    const bf16* U = (const bf16*)(p.ws + WS_U) + (size_t)(b * S5NG + g) * SEQ * 16;
    unsigned char* Z = p.ws + WS_Z;
    const float st = __expf(p.in[I_LSTEP][g]);
    const float* lre = p.in[I_LRE] + g * 64; const float* lim = p.in[I_LIM] + g * 64;
    float ar, ai; { const float lr = lre[lane], li = lim[lane]; const float ea = __expf(lr * st); float sn, cs; sincos_acc(li * st, sn, cs); ar = ea * cs; ai = ea * sn; }
    const int half = lane >> 5, l31 = lane & 31;
    bf16x8 bfrag[4];
#pragma unroll
    for (int nt = 0; nt < 4; ++nt) { const int pp = 16 * nt + (l31 >> 1); const bool im = (l31 & 1) != 0;
        const float lr = lre[pp], li = lim[pp]; const float ea = __expf(lr * st); float sn, cs; sincos_acc(li * st, sn, cs);
        const float nr = ea * cs - 1.0f, ni = ea * sn, d2 = lr * lr + li * li; const float qr = (nr * lr + ni * li) / d2, qi = (ni * lr - nr * li) / d2;
        const float* brp = p.in[I_BRE] + ((size_t)(g * 64 + pp) * 16 + 8 * half); const float* bip = p.in[I_BIM] + ((size_t)(g * 64 + pp) * 16 + 8 * half);
        const f32x4 br0 = *(const f32x4*)brp, br1 = *(const f32x4*)(brp + 4), bi0 = *(const f32x4*)bip, bi1 = *(const f32x4*)(bip + 4);
        float o[8];
#pragma unroll
        for (int j = 0; j < 8; ++j) { const float br = j < 4 ? br0[j] : br1[j - 4], bi = j < 4 ? bi0[j] : bi1[j - 4]; o[j] = im ? (qr * bi + qi * br) : (qr * br - qi * bi); }
        bfrag[nt] = __builtin_bit_cast(bf16x8, pack8(o)); }
    const int hh = lane & 15, q4 = lane >> 4;
    bf16x8 cfrag[4];
#pragma unroll
    for (int ks = 0; ks < 4; ++ks) { const int pb = 16 * ks + 4 * q4;
        const f32x4 cr = *(const f32x4*)(p.in[I_CRE] + ((size_t)(g * 16 + hh) * 64 + pb)), ci = *(const f32x4*)(p.in[I_CIM] + ((size_t)(g * 16 + hh) * 64 + pb));
        float o[8];
#pragma unroll
        for (int j = 0; j < 4; ++j) { o[2 * j] = cr[j]; o[2 * j + 1] = -ci[j]; }
        cfrag[ks] = __builtin_bit_cast(bf16x8, pack8(o)); }
    const f32x4 dsk = *(const f32x4*)(p.in[I_SD] + g * 16 + 4 * q4);
    float xr = 0.f, xi = 0.f;
    const bf16* ua = U + (size_t)l31 * 16 + 8 * half;
    const bf16* ud = U + (size_t)hh * 16 + 4 * q4;
    bf16x8 au_n = *(const bf16x8*)ua; v2u uq_n0 = *(const v2u*)ud, uq_n1 = *(const v2u*)(ud + 16 * 16);
    for (int sc = 0; sc < SEQ / 32; ++sc) {
        const size_t row0 = (size_t)b * SEQ + sc * 32;
        const bf16x8 au = au_n; const v2u uqs[2] = {uq_n0, uq_n1};
        if (sc + 1 < SEQ / 32) { au_n = *(const bf16x8*)(ua + (size_t)(sc + 1) * 512); uq_n0 = *(const v2u*)(ud + (size_t)(sc + 1) * 512); uq_n1 = *(const v2u*)(ud + (size_t)(sc + 1) * 512 + 256); }
        f32x16 acc[4];
#pragma unroll
        for (int nt = 0; nt < 4; ++nt) {
#pragma unroll
            for (int i = 0; i < 16; ++i) acc[nt][i] = 0.f;
            acc[nt] = __builtin_amdgcn_mfma_f32_32x32x16_bf16(au, bfrag[nt], acc[nt], 0, 0, 0); }
#pragma unroll
        for (int nt = 0; nt < 4; ++nt)
#pragma unroll
            for (int i = 0; i < 16; ++i) { const int t = (i & 3) + 8 * (i >> 2) + 4 * half; BU[t * S5_BU_PITCH + 32 * nt + l31] = acc[nt][i]; }
        LDS_WAIT();
#pragma unroll
        for (int hb = 0; hb < 2; ++hb) {
            pg8::f32x2_ bb[16];
#pragma unroll
            for (int t = 0; t < 16; ++t) bb[t] = *(const LAS pg8::f32x2_*)(BU + (16 * hb + t) * S5_BU_PITCH + 2 * lane);
#pragma unroll
            for (int t = 0; t < 16; ++t) { const float nr = ar * xr - ai * xi + bb[t].x, ni = ar * xi + ai * xr + bb[t].y; xr = nr; xi = ni;
                *(LAS unsigned*)(XS + (16 * hb + t) * S5_XS_PITCH + 2 * lane) = pg8::cvt_pk_bf16(xr, xi); } }
        LDS_WAIT();
#pragma unroll
        for (int nt = 0; nt < 2; ++nt) {
            f32x4 ay = (f32x4){0.f, 0.f, 0.f, 0.f};
#pragma unroll
            for (int ks = 0; ks < 4; ++ks) { const bf16x8 xb = *(const LAS bf16x8*)(XS + (16 * nt + hh) * S5_XS_PITCH + 32 * ks + 8 * q4);
                ay = __builtin_amdgcn_mfma_f32_16x16x32_bf16(cfrag[ks], xb, ay, 0, 0, 0); }
            const size_t row = row0 + 16 * nt + hh;
            const v2u uq = uqs[nt];
            const float y0 = ay[0] + dsk[0] * bflo(uq.x), y1 = ay[1] + dsk[1] * bfhi(uq.x), y2 = ay[2] + dsk[2] * bflo(uq.y), y3 = ay[3] + dsk[3] * bfhi(uq.y);
            constexpr float zs = (float)(1 << GLU_Z_SH);
            *(unsigned*)(Z + row * S5W + g * 16 + 4 * q4) = pk4_fp8(gelu_tanh(y0) * zs, gelu_tanh(y1) * zs, gelu_tanh(y2) * zs, gelu_tanh(y3) * zs); }
        LDS_WAIT();
    }
}

__device__ __forceinline__ void moe_tables(const unsigned* cnt, LAS int* tb, LAS int* cntl, int tid) {
    if (tid < NEXP) cntl[tid] = (int)__hip_atomic_load(cnt + tid, __ATOMIC_RELAXED, __HIP_MEMORY_SCOPE_AGENT);
    __syncthreads();
    if (tid == 0) { int s = 0; for (int e = 0; e < NEXP; ++e) { tb[e] = s; s += (cntl[e] + 255) >> 8; } tb[NEXP] = s; }
    __syncthreads();
}
__device__ __forceinline__ void p7_pass2(const bf16* __restrict__ xr, const bf16* __restrict__ rt, const float* __restrict__ gain, unsigned char* __restrict__ h8, float rs, f32x4 (&acc)[3]) {
#pragma unroll 8
    for (int ks = 0; ks < 64; ++ks) { float x8[8]; unpack8(*(const v4u*)(xr + 32 * ks), x8);
        const f32x4 g0 = *(const f32x4*)(gain + 32 * ks), g1 = *(const f32x4*)(gain + 32 * ks + 4);
#pragma unroll
        for (int j = 0; j < 8; ++j) x8[j] = x8[j] * rs * (j < 4 ? g0[j] : g1[j - 4]);
        const bf16x8 a = __builtin_bit_cast(bf16x8, pack8(x8));
        *(v2u*)(h8 + 32 * ks) = (v2u){pk4_fp8(x8[0], x8[1], x8[2], x8[3]), pk4_fp8(x8[4], x8[5], x8[6], x8[7])};
#pragma unroll
        for (int nt = 0; nt < 3; ++nt) { const bf16x8 b = *(const bf16x8*)(rt + (size_t)(16 * nt) * D + 32 * ks); acc[nt] = __builtin_amdgcn_mfma_f32_16x16x32_bf16(a, b, acc[nt], 0, 0, 0); } }
}
__device__ __forceinline__ void p7_norm_route(const Params& p, LAS unsigned char* lds, int tid, int wave, int lane) {
    LAS int* hist = (LAS int*)lds; LAS int* hb = hist + 32;
    LAS float* LGW = (LAS float*)(lds + 1024 + wave * 3328);
    const bf16* X1 = (const bf16*)(p.ws + WS_X1); const bf16* RT = (const bf16*)(p.ws + WS_RT); unsigned char* H8 = p.ws + WS_H28; const float* gain = p.in[I_NFG];
    unsigned* cnt = (unsigned*)(p.ws + WS_CTL) + CW_CNT; int* toki = (int*)(p.ws + WS_TOKI); float* tokw = (float*)(p.ws + WS_TOKW); int* list = (int*)(p.ws + WS_LIST);
    const int m = lane & 15, kq = lane >> 4;
    for (int base = blockIdx.x * 128; base < M; base += gridDim.x * 128) {
        if (tid < 32) hist[tid] = 0;
        __syncthreads();
        const int row = base + wave * 16 + m;
        const bf16* xr = X1 + (size_t)row * D + 8 * kq;
        float s = 0.f;
#pragma unroll 16
        for (int ks = 0; ks < 64; ++ks) { float x8[8]; unpack8(*(const v4u*)(xr + 32 * ks), x8);
#pragma unroll
            for (int j = 0; j < 8; ++j) s += x8[j] * x8[j]; }
        s += __shfl_xor(s, 16); s += __shfl_xor(s, 32);
        const float rs = 1.0f / sqrtf(s * (1.f / D) + RMS_EPS);
        f32x4 acc[3] = {(f32x4){0.f, 0.f, 0.f, 0.f}, (f32x4){0.f, 0.f, 0.f, 0.f}, (f32x4){0.f, 0.f, 0.f, 0.f}};
        p7_pass2(xr, RT + (size_t)m * D + 8 * kq, gain + 8 * kq, H8 + (size_t)row * D + 8 * kq, rs, acc);
#pragma unroll
        for (int nt = 0; nt < 3; ++nt)
#pragma unroll
            for (int rr = 0; rr < 4; ++rr) LGW[(4 * kq + rr) * 52 + 16 * nt + m] = acc[nt][rr];
        LDS_WAIT();
        int e0 = 0, e1 = 0, r0 = 0, r1 = 0; float w0 = 0.f, w1 = 0.f; const int tok = base + wave * 16 + lane;
        if (lane < 16) {
            const LAS float* lg = LGW + lane * 52;
            float gl[4]; int gi = 0; float gm;
#pragma unroll
            for (int j = 0; j < 4; ++j) gl[j] = lg[j] + p.in[I_RGB][j];
            gm = gl[0];
#pragma unroll
            for (int j = 1; j < 4; ++j) if (gl[j] > gm) { gm = gl[j]; gi = j; }
            float den = 0.f;
#pragma unroll
            for (int j = 0; j < 4; ++j) den += __expf(gl[j] - gm);
            const float gp = 1.0f / den;
            float l0 = -3.0e38f, l1 = -3.0e38f; int i0 = 0, i1 = 0;
#pragma unroll
            for (int j = 0; j < 8; ++j) { const float v = lg[4 + gi * 8 + j] + p.in[I_REB][gi * 8 + j];
                if (v > l0) { l1 = l0; i1 = i0; l0 = v; i0 = j; } else if (v > l1) { l1 = v; i1 = j; } }
            const float ex = __expf(l1 - l0); w0 = gp / (1.0f + ex); w1 = gp * ex / (1.0f + ex);
            e0 = gi * 8 + i0; e1 = gi * 8 + i1;
            r0 = __hip_atomic_fetch_add(&hist[e0], 1, __ATOMIC_RELAXED, __HIP_MEMORY_SCOPE_WORKGROUP); r1 = __hip_atomic_fetch_add(&hist[e1], 1, __ATOMIC_RELAXED, __HIP_MEMORY_SCOPE_WORKGROUP);
        }
        __syncthreads();
        if (tid < 32) { const int c = hist[tid]; hb[tid] = c ? (int)__hip_atomic_fetch_add(cnt + tid, (unsigned)c, __ATOMIC_RELAXED, __HIP_MEMORY_SCOPE_AGENT) : 0; }
        __syncthreads();
        if (lane < 16) { const int p0 = hb[e0] + r0, p1 = hb[e1] + r1;
            list[(size_t)e0 * CAP + p0] = tok; list[(size_t)e1 * CAP + p1] = tok;
            *(int4*)(toki + (size_t)tok * 4) = make_int4(e0, e1, p0, p1); *(float2*)(tokw + (size_t)tok * 2) = make_float2(w0, w1); }
        __syncthreads();
    }
}
__device__ __forceinline__ void p11_final(const Params& p, const LAS int* tb, int gw, int NGW, int lane) {
    const unsigned char* Y2 = p.ws + WS_Y2; const bf16* X1 = (const bf16*)(p.ws + WS_X1); const int* toki = (const int*)(p.ws + WS_TOKI); const float* tokw = (const float*)(p.ws + WS_TOKW);
    f32x4 g[8];
#pragma unroll
    for (int j = 0; j < 8; ++j) g[j] = ((const f32x4*)p.in[I_NFIN] + lane)[64 * j];
    if (gw >= M) return;
    const float ysc = 1.0f / (float)(1 << Y2_SH);
    int4 ti = *(const int4*)(toki + (size_t)gw * 4); float2 tw = *(const float2*)(tokw + (size_t)gw * 2);
    v2u xw[8], xwn[8]; unsigned ya[8], yc[8], yan[8], ycn[8];
    { const size_t q0 = (size_t)tb[ti.x] * 256 + ti.z, q1 = (size_t)tb[ti.y] * 256 + ti.w;
#pragma unroll
      for (int j = 0; j < 8; ++j) { xw[j] = ((const v2u*)(X1 + (size_t)gw * D) + lane)[64 * j]; ya[j] = ((const unsigned*)(Y2 + q0 * D) + lane)[64 * j]; yc[j] = ((const unsigned*)(Y2 + q1 * D) + lane)[64 * j]; } }
    int m1 = gw + NGW < M ? gw + NGW : gw;
    int4 tin = *(const int4*)(toki + (size_t)m1 * 4); float2 twn = *(const float2*)(tokw + (size_t)m1 * 2);
    for (int m = gw; m < M; m += NGW) {
        const int mn = m + NGW < M ? m + NGW : m, mnn = mn + NGW < M ? mn + NGW : mn;
        { const size_t q0 = (size_t)tb[tin.x] * 256 + tin.z, q1 = (size_t)tb[tin.y] * 256 + tin.w;
#pragma unroll
          for (int j = 0; j < 8; ++j) { xwn[j] = ((const v2u*)(X1 + (size_t)mn * D) + lane)[64 * j]; yan[j] = ((const unsigned*)(Y2 + q0 * D) + lane)[64 * j]; ycn[j] = ((const unsigned*)(Y2 + q1 * D) + lane)[64 * j]; } }
        const int4 tinn = *(const int4*)(toki + (size_t)mnn * 4); const float2 twnn = *(const float2*)(tokw + (size_t)mnn * 2);
        const float w0 = tw.x * ysc, w1 = tw.y * ysc;
        f32x4 v[8]; float s = 0.f;
#pragma unroll
        for (int j = 0; j < 8; ++j) {
            const pg8::f32x2_ a0 = __builtin_amdgcn_cvt_pk_f32_fp8((int)ya[j], false), a1 = __builtin_amdgcn_cvt_pk_f32_fp8((int)ya[j], true), c0 = __builtin_amdgcn_cvt_pk_f32_fp8((int)yc[j], false), c1 = __builtin_amdgcn_cvt_pk_f32_fp8((int)yc[j], true);
            f32x4 x; x.x = bflo(xw[j].x) + w0 * a0[0] + w1 * c0[0]; x.y = bfhi(xw[j].x) + w0 * a0[1] + w1 * c0[1]; x.z = bflo(xw[j].y) + w0 * a1[0] + w1 * c1[0]; x.w = bfhi(xw[j].y) + w0 * a1[1] + w1 * c1[1];
            v[j] = x; s += (x.x * x.x + x.y * x.y) + (x.z * x.z + x.w * x.w); }
        const float rs = 1.0f / sqrtf(wave_sum(s) * (1.f / D) + RMS_EPS);
        f32x4* orow = (f32x4*)(p.out + (size_t)m * D) + lane;
#pragma unroll
        for (int j = 0; j < 8; ++j) orow[64 * j] = v[j] * rs * g[j];
#pragma unroll
        for (int j = 0; j < 8; ++j) { xw[j] = xwn[j]; ya[j] = yan[j]; yc[j] = ycn[j]; }
        tw = twn; tin = tinn; twn = twnn; (void)ti;
    }
}

__device__ __forceinline__ void phase_0(const Params& p, LAS unsigned char* lds, unsigned char* ws, unsigned* ctl, LAS int* tb, LAS int* cntl, int G, int tid, int wave, int lane, int gw, int NGW) { p0_prologue(p, lds, gw, NGW, wave, lane); }
__device__ __forceinline__ void phase_1(const Params& p, LAS unsigned char* lds, unsigned char* ws, unsigned* ctl, LAS int* tb, LAS int* cntl, int G, int tid, int wave, int lane, int gw, int NGW) {
    {
        pg8::Gemm g{ws + WS_H, ws + WS_WIN, D}; pg8::StaticOrder S; S.init(M, 3 * RW, G, (int)blockIdx.x);
        EpiProj E{(bf16*)(ws + WS_PR), (bf16*)(ws + WS_U), 0};
        pg8::gemm_phase<EpiProj, pg8::StaticOrder, true>(lds, g, S, E); }
    {
        pg8::Gemm g{ws + WS_H28, ws + WS_WINU8, D, 127 * 0x01010101, (127 - MOE_WGU_SH) * 0x01010101}; pg8::StaticOrder S; S.init(M, 512 + S5W, G, (int)blockIdx.x);
        EpiProj E{(bf16*)(ws + WS_PR), (bf16*)(ws + WS_U), 12};
        pg8::gemm_phase<EpiProj, pg8::StaticOrder, true, true>(lds, g, S, E); }
}
__device__ __forceinline__ void lin_pass(const Params& p, unsigned char* ws, int tix, int nthreads) {
    const bf16* LOR = (const bf16*)(ws + WS_PR) + (size_t)M * (3 * RW); bf16* LIN = (bf16*)(ws + WS_LIN); const float* mu = p.in[I_MU] + 3 * RW;
    constexpr int NIT = M * (LORA / 8);
    for (int it0 = tix; it0 < NIT; it0 += 4 * nthreads) {
        v4u cq[4], pq[4]; int rows[4], cols[4];
#pragma unroll
        for (int k = 0; k < 4; ++k) { const int it = it0 + k * nthreads; const int itc = it < NIT ? it : it0; rows[k] = itc / (LORA / 8); cols[k] = 8 * (itc - rows[k] * (LORA / 8));
            cq[k] = *(const v4u*)(LOR + (size_t)rows[k] * 512 + cols[k]); pq[k] = (v4u){0u, 0u, 0u, 0u}; if ((rows[k] & (SEQ - 1)) != 0) pq[k] = *(const v4u*)(LOR + (size_t)(rows[k] - 1) * 512 + cols[k]); }
#pragma unroll
        for (int k = 0; k < 4; ++k) { const int col = cols[k];
            const f32x4 m0 = *(const f32x4*)(mu + col), m1 = *(const f32x4*)(mu + col + 4);
            float c8[8], p8[8]; unpack8(cq[k], c8); unpack8(pq[k], p8);
#pragma unroll
            for (int j = 0; j < 8; ++j) { float x = c8[j] + (p8[j] - c8[j]) * (j < 4 ? m0[j] : m1[j - 4]); if (col < DEC_R) x = tanh_fast(x); else if (col >= DEC_R + AAA_R) x = sigmoidf_(x); c8[j] = x; }
            if (it0 + k * nthreads < NIT) *(v4u*)(LIN + (size_t)rows[k] * LORA + col) = pack8(c8); } }
}
__device__ __forceinline__ void phase_2(const Params& p, LAS unsigned char* lds, unsigned char* ws, unsigned* ctl, LAS int* tb, LAS int* cntl, int G, int tid, int wave, int lane, int gw, int NGW) {
    if (wave < 4) { for (int u = blockIdx.x * 4 + wave; u < BATCH * S5NG; u += G * 4) s5_unit(p, u, lds + wave * S5_WAVE_LDS, lane); }
    else { lin_pass(p, ws, (blockIdx.x * 4 + (wave - 4)) * 64 + lane, G * 256);
           p2_convert(p, (LAS float*)(lds + 4 * S5_WAVE_LDS + (wave - 4) * 8448), blockIdx.x * 4 + (wave - 4), G * 4, lane); }
    __syncthreads();
}
__device__ __forceinline__ void phase_3(const Params& p, LAS unsigned char* lds, unsigned char* ws, unsigned* ctl, LAS int* tb, LAS int* cntl, int G, int tid, int wave, int lane, int gw, int NGW) {
    for (int u = blockIdx.x; u < BATCH * RHEADS; u += G) rwkv_unit_c(p, u, lds, wave, lane);
    __syncthreads();
}
__device__ __forceinline__ void phase_4(const Params& p, LAS unsigned char* lds, unsigned char* ws, unsigned* ctl, LAS int* tb, LAS int* cntl, int G, int tid, int wave, int lane, int gw, int NGW) {
    {
        pg8::Gemm g{ws + WS_YA, ws + WS_WRO, RW}; pg8::StaticOrder S; S.init(M, D, G, (int)blockIdx.x);
        EpiYa E{(bf16*)(ws + WS_YAO)};
        pg8::gemm_phase<EpiYa, pg8::StaticOrder, true>(lds, g, S, E); }
    {
        pg8::Gemm g{ws + WS_Z, ws + WS_WGL, S5W, (127 - GLU_Z_SH) * 0x01010101, (127 - GLU_W_SH) * 0x01010101}; pg8::StaticOrder S; S.init(M, 2 * D, G, (int)blockIdx.x);
        EpiGlu E{(bf16*)(ws + WS_YBO)};
        pg8::gemm_phase<EpiGlu, pg8::StaticOrder, true, true>(lds, g, S, E); }
}
__device__ __forceinline__ void phase_5(const Params& p, LAS unsigned char* lds, unsigned char* ws, unsigned* ctl, LAS int* tb, LAS int* cntl, int G, int tid, int wave, int lane, int gw, int NGW) {
    pg8::Gemm g{ws + WS_H28, ws + WS_WIN8, D, 127 * 0x01010101, (127 - MOE_WGU_SH) * 0x01010101}; pg8::StaticOrder S; S.init(M, 2 * D, G, (int)blockIdx.x);
    EpiMerge E{(const bf16*)(ws + WS_YAO), (const bf16*)(ws + WS_YBO), ws + WS_MIX};
    pg8::gemm_phase<EpiMerge, pg8::StaticOrder, true, true>(lds, g, S, E);
}
__device__ __forceinline__ void phase_6(const Params& p, LAS unsigned char* lds, unsigned char* ws, unsigned* ctl, LAS int* tb, LAS int* cntl, int G, int tid, int wave, int lane, int gw, int NGW) { pg8::Gemm g{ws + WS_MIX, ws + WS_WO, D, (127 - MIX_SH) * 0x01010101, (127 - WO_W_SH) * 0x01010101}; pg8::StaticOrder S; S.init(M, D, G, (int)blockIdx.x);
        EpiX1 E{p.in[I_X], (bf16*)(ws + WS_X1)};
        pg8::gemm_phase<EpiX1, pg8::StaticOrder, true, true>(lds, g, S, E); }
__device__ __forceinline__ void phase_7(const Params& p, LAS unsigned char* lds, unsigned char* ws, unsigned* ctl, LAS int* tb, LAS int* cntl, int G, int tid, int wave, int lane, int gw, int NGW) { p7_norm_route(p, lds, tid, wave, lane); }
__device__ __forceinline__ void phase_10(const Params& p, LAS unsigned char* lds, unsigned char* ws, unsigned* ctl, LAS int* tb, LAS int* cntl, int G, int tid, int wave, int lane, int gw, int NGW) { moe_tables(ctl + CW_CNT, tb, cntl, tid);
        pg8::Gemm g{ws + WS_H28, ws + WS_MGU, D, 127 * 0x01010101, (127 - MOE_WGU_SH) * 0x01010101}; MoeOrder S{tb, cntl, (const int*)(ws + WS_LIST), 4, G, (int)blockIdx.x, true};
        EpiMoeGU E{ws + WS_HID};
        pg8::gemm_phase<EpiMoeGU, MoeOrder, true, true>(lds, g, S, E); }
__device__ __forceinline__ void phase_11(const Params& p, LAS unsigned char* lds, unsigned char* ws, unsigned* ctl, LAS int* tb, LAS int* cntl, int G, int tid, int wave, int lane, int gw, int NGW) { moe_tables(ctl + CW_CNT, tb, cntl, tid);
        pg8::Gemm g{ws + WS_HID, ws + WS_MD, DEXP, (127 - MOE_HID_SH) * 0x01010101, (127 - MOE_WD_SH) * 0x01010101}; MoeOrder S{tb, cntl, (const int*)(ws + WS_LIST), 8, G, (int)blockIdx.x, false};
        EpiMoeDown E{ws + WS_Y2};
        pg8::gemm_phase<EpiMoeDown, MoeOrder, true, true>(lds, g, S, E); }
__device__ __forceinline__ void phase_12(const Params& p, LAS unsigned char* lds, unsigned char* ws, unsigned* ctl, LAS int* tb, LAS int* cntl, int G, int tid, int wave, int lane, int gw, int NGW) { moe_tables(ctl + CW_CNT, tb, cntl, tid); p11_final(p, tb, gw, NGW, lane); }

#ifndef MK_ONE_LAUNCH
#define MK_ONE_LAUNCH 1
#endif
constexpr int N_PHASES = 13;
__global__ void __launch_bounds__(NTHR, 2) hyb_fwd(Params p) {
    extern __shared__ __attribute__((aligned(16))) unsigned char lds_raw[];
    LAS unsigned char* lds = (LAS unsigned char*)lds_raw;
    const int tid = threadIdx.x, lane = tid & 63, wave = __builtin_amdgcn_readfirstlane(tid >> 6);
    const int G = gridDim.x;
    const int gw = blockIdx.x * NWAVES + wave, NGW = G * NWAVES;
    unsigned char* ws = p.ws;
    unsigned* ctl = (unsigned*)(ws + WS_CTL);
    LAS unsigned char* lds0 = lds; lds = lds0 + RING_OFF;
    for (int u = tid; u < RING_OFF / 4; u += NTHR) ((LAS unsigned*)(lds0 + LDSCTL_OFF))[u] = 0u;
    __syncthreads();
    LAS int* tb = (LAS int*)(lds0 + LDSCTL_OFF); LAS int* cntl = tb + 40;
    volatile LAS unsigned* MISC = (volatile LAS unsigned*)(lds0 + MISC_OFF);
    const int lo = p.ph_lo, hi = p.ph_hi;
    XcdBarrier bar; bar.bar = ctl + CW_BAR; bar.x = 0; bar.st = nullptr;
    if (hi - lo > 1) bar = xcd_barrier_post(ctl + CW_BAR, MISC + 8);
#define IN(k) (lo <= (k) && (k) < hi)
#define SEAM(k) do { if (IN(k) && IN((k) + 1)) xcd_barrier(bar); } while (0)

    if (IN(0)) { phase_0(p, lds, ws, ctl, tb, cntl, G, tid, wave, lane, gw, NGW); }
    SEAM(0);
    if (IN(1)) { phase_1(p, lds, ws, ctl, tb, cntl, G, tid, wave, lane, gw, NGW); }
    SEAM(1);
    if (IN(2)) { phase_2(p, lds, ws, ctl, tb, cntl, G, tid, wave, lane, gw, NGW); }
    SEAM(2);
    if (IN(3)) { phase_3(p, lds, ws, ctl, tb, cntl, G, tid, wave, lane, gw, NGW); }
    SEAM(3);
    if (IN(4)) { phase_4(p, lds, ws, ctl, tb, cntl, G, tid, wave, lane, gw, NGW); }
    SEAM(4);
    if (IN(5)) { phase_5(p, lds, ws, ctl, tb, cntl, G, tid, wave, lane, gw, NGW); }
    SEAM(5);
    if (IN(6)) { phase_6(p, lds, ws, ctl, tb, cntl, G, tid, wave, lane, gw, NGW); }
    SEAM(6);
    if (IN(7)) { phase_7(p, lds, ws, ctl, tb, cntl, G, tid, wave, lane, gw, NGW); }
    SEAM(7);
    if (IN(10)) { phase_10(p, lds, ws, ctl, tb, cntl, G, tid, wave, lane, gw, NGW); }
    SEAM(10);
    if (IN(11)) { phase_11(p, lds, ws, ctl, tb, cntl, G, tid, wave, lane, gw, NGW); }
    SEAM(11);
    if (IN(12)) { phase_12(p, lds, ws, ctl, tb, cntl, G, tid, wave, lane, gw, NGW); }
#undef IN
#undef SEAM
}

extern "C" void kernel_launch(void* const* d_in, const int* in_sizes, int n_in, void* d_out, int out_size, void* d_ws, size_t ws_size, hipStream_t stream) {
    static int grid = 0;
    if (grid == 0) {
        if (n_in != 35 || out_size != M * D || ws_size < WS_END) { fprintf(stderr, "kernel_launch: unexpected problem (n_in %d out %d ws %zu, need %zu)\n", n_in, out_size, ws_size, (size_t)WS_END); grid = -1; return; }
        int dev = 0, cus = 0, per_cu = 0;
        if (hipGetDevice(&dev) != hipSuccess || hipDeviceGetAttribute(&cus, hipDeviceAttributeMultiprocessorCount, dev) != hipSuccess) { grid = -1; return; }
        if (hipFuncSetAttribute((const void*)hyb_fwd, hipFuncAttributeMaxDynamicSharedMemorySize, LDS_BYTES) != hipSuccess) { fprintf(stderr, "kernel_launch: hipFuncSetAttribute failed\n"); grid = -1; return; }
        if (hipOccupancyMaxActiveBlocksPerMultiprocessor(&per_cu, (const void*)hyb_fwd, NTHR, LDS_BYTES) != hipSuccess || per_cu < 1) fprintf(stderr, "kernel_launch: occupancy query says %d\n", per_cu);
        (void)hipGetLastError();
        grid = cus;
    }
    if (grid < 0) return;
    if (hipMemsetAsync((char*)d_ws + WS_CTL, 0, CTL_ZERO_BYTES, stream) != hipSuccess) return;
    Params p{};
    for (int i = 0; i < 35; ++i) p.in[i] = (const float*)d_in[i];
    p.out = (float*)d_out; p.ws = (unsigned char*)d_ws;
#if MK_ONE_LAUNCH
    p.ph_lo = 0; p.ph_hi = N_PHASES;
    hipLaunchKernelGGL(hyb_fwd, dim3(grid), dim3(NTHR), LDS_BYTES, stream, p);
#else
    for (int ph = 0; ph < N_PHASES; ++ph) { p.ph_lo = ph; p.ph_hi = ph + 1; hipLaunchKernelGGL(hyb_fwd, dim3(grid), dim3(NTHR), LDS_BYTES, stream, p); }
#endif
}
```

```cpp
#include <hip/hip_runtime.h>
#include <cstdio>
#include <cstdint>

namespace pg8 {
#define PG8_LAS __attribute__((address_space(3)))
typedef unsigned short bf16_t;
typedef short bf16x8 __attribute__((ext_vector_type(8)));
typedef float f32x4 __attribute__((ext_vector_type(4)));
typedef unsigned u32x4 __attribute__((ext_vector_type(4)));
typedef unsigned u32x2 __attribute__((ext_vector_type(2)));
constexpr int BM = 256, BK = 64, HALF = 128, HTB = HALF * BK * 2  , STAGE_BYTES = 8 * HTB, NXCD = 8, WGM = 8;

__host__ __device__ __forceinline__ int lds_byte(int r, int c) { const int st = (r >> 4) * 2 + (c >> 5), rr = r & 15, cc = c & 31, ob = rr * 64 + cc * 2; return st * 1024 + (ob ^ (((ob >> 9) & 1) << 5)); }
__host__ __device__ __forceinline__ void stage_rc(int b, int& R, int& C) { const int st = b / 1024, sb = b % 1024, swz = sb ^ (((sb >> 9) & 1) << 5); R = (st >> 1) * 16 + swz / 64; C = (st & 1) * 32 + (swz % 64) / 2; }
__host__ __device__ __forceinline__ int perm32(int rho) { const int n = rho >> 4, i = rho & 15; return 8 * (i >> 2) + 4 * n + (i & 3); }

struct Unit { int pm, pn, e, rt; };
struct Gemm { const void* A; const void* Bt; int K; int sa, sb; };
typedef int v8i32 __attribute__((ext_vector_type(8)));

struct StaticOrder {
    int nM, nN, nwg, G, c;
    __host__ __device__ void init(int M, int N, int G_, int c_) { nM = M / BM; nN = N / BM; nwg = nM * nN; G = G_; c = c_; }
    __host__ __device__ bool next(int i, Unit& u) const {
        const long L = (long)i * G + c; if (L >= nwg) return false;
        int wgid = (int)L; { const int q = nwg / NXCD, r = nwg % NXCD, xcd = wgid % NXCD, off = wgid / NXCD; wgid = (xcd < r ? xcd * (q + 1) : r * (q + 1) + (xcd - r) * q) + off; }
        const int nig = WGM * nN, gid = wgid / nig, fm = gid * WGM, gsz = (nM - fm) < WGM ? (nM - fm) : WGM;
        u.pm = fm + ((wgid % nig) % gsz); u.pn = (wgid % nig) / gsz; u.e = 0; u.rt = 0; return true;
    }
    __device__ __forceinline__ int arow(const Unit& u, int r) const { return u.pm * BM + r; }
};

typedef float f32x2_ __attribute__((ext_vector_type(2))); typedef __bf16 bf16x2_ __attribute__((ext_vector_type(2)));
__device__ __forceinline__ unsigned cvt_pk_bf16(float lo, float hi) { const f32x2_ v = {lo, hi}; return __builtin_bit_cast(unsigned, __builtin_convertvector(v, bf16x2_)); }

template <class Epi, class Sched, bool ALIGN_EPI, bool FP8 = false>
__device__ __forceinline__ void gemm_phase(PG8_LAS unsigned char* lds, const Gemm g, const Sched& S, const Epi& E) {
    const int tid = threadIdx.x, wid = __builtin_amdgcn_readfirstlane(tid >> 6), lane = tid & 63, wr = wid >> 2, wc = wid & 3, fr = lane & 15, fq = lane >> 4;
    constexpr int EB = FP8 ? 1 : 2;
    const int K = g.K, nt = K * EB / (BK * 2);
    int RA[2]; unsigned coffA[2], voffB[2];
#pragma unroll
    for (int i = 0; i < 2; ++i) { int R, C; stage_rc(tid * 16 + i * 8192, R, C); const int Rb = Epi::PERM ? ((R & ~31) + perm32(R & 31)) : R;
        RA[i] = R; coffA[i] = (unsigned)C * 2u; voffB[i] = (unsigned)(Rb * K) * (unsigned)EB + (unsigned)C * 2u; }
    const unsigned rowb = (unsigned)K * (unsigned)EB;
    const size_t kstep = (size_t)(BK * 2);
    const size_t hstep = (size_t)HALF * K * EB;
    const size_t tstep = 2 * hstep;
    const unsigned ldsw = (unsigned)wid * 1024u;
    const int aoff = lds_byte(wr * 64 + fr, FP8 ? fq * 16 : fq * 8), boff = lds_byte(wc * 32 + fr, FP8 ? fq * 16 : fq * 8);
    constexpr int KS2 = FP8 ? 16 : 1024;
    const char* gA = (const char*)g.A;
#define PG8_SA(b, h) (((b) * 2 + (h)) * HTB)
#define PG8_SB(b, h) ((4 + (b) * 2 + (h)) * HTB)
#define PG8_STAGE(bufoff, gbase, voff) do { _Pragma("unroll") for (int _i = 0; _i < 2; ++_i) \
        __builtin_amdgcn_global_load_lds((const unsigned*)((const char*)(gbase) + (voff)[_i]), (PG8_LAS unsigned*)(lds + (bufoff) + ldsw + _i * 8192), 16, 0, 0); } while (0)
#define PG8_LDA(dst, b, h) do { _Pragma("unroll") for (int m = 0; m < 4; ++m) _Pragma("unroll") for (int k = 0; k < 2; ++k) dst[m][k] = *(const PG8_LAS bf16x8*)(lds + PG8_SA(b, h) + aoff + m * 2048 + k * KS2); } while (0)
#define PG8_LDB(dst, b, h) do { _Pragma("unroll") for (int n = 0; n < 2; ++n) _Pragma("unroll") for (int k = 0; k < 2; ++k) dst[n][k] = *(const PG8_LAS bf16x8*)(lds + PG8_SB(b, h) + boff + n * 2048 + k * KS2); } while (0)
#define PG8_MMA(ai, bj, At, Bt) do { __builtin_amdgcn_s_setprio(1); _Pragma("unroll") for (int m = 0; m < 4; ++m) _Pragma("unroll") for (int n = 0; n < 2; ++n) { \
        if constexpr (FP8) { const u32x4 _b0 = __builtin_bit_cast(u32x4, Bt[n][0]), _b1 = __builtin_bit_cast(u32x4, Bt[n][1]), _a0 = __builtin_bit_cast(u32x4, At[m][0]), _a1 = __builtin_bit_cast(u32x4, At[m][1]); \
            acc[ai][bj][m][n] = __builtin_amdgcn_mfma_scale_f32_16x16x128_f8f6f4((v8i32){(int)_b0.x, (int)_b0.y, (int)_b0.z, (int)_b0.w, (int)_b1.x, (int)_b1.y, (int)_b1.z, (int)_b1.w}, \
                (v8i32){(int)_a0.x, (int)_a0.y, (int)_a0.z, (int)_a0.w, (int)_a1.x, (int)_a1.y, (int)_a1.z, (int)_a1.w}, acc[ai][bj][m][n], 0, 0, 0, g.sb, 0, g.sa); } \
        else { _Pragma("unroll") for (int k = 0; k < 2; ++k) acc[ai][bj][m][n] = __builtin_amdgcn_mfma_f32_16x16x32_bf16(Bt[n][k], At[m][k], acc[ai][bj][m][n], 0, 0, 0); } } \
        __builtin_amdgcn_s_setprio(0); } while (0)
#define PG8_WAIT_V(n) asm volatile("s_waitcnt vmcnt(" #n ")" ::: "memory")
#define PG8_WAIT_L(n) asm volatile("s_waitcnt lgkmcnt(" #n ")" ::: "memory")
#define PG8_BAR __builtin_amdgcn_s_barrier()
#define PG8_SCHED __builtin_amdgcn_sched_barrier(0)
    Unit cur, nxt; int ui = 0;
    if (!S.next(0, cur)) return;
    f32x4 acc[2][2][4][2];
#pragma unroll
    for (int a = 0; a < 2; ++a)
#pragma unroll
        for (int b = 0; b < 2; ++b)
#pragma unroll
            for (int m = 0; m < 4; ++m)
#pragma unroll
                for (int n = 0; n < 2; ++n) acc[a][b][m][n] = (f32x4){0.f, 0.f, 0.f, 0.f};
    bf16x8 At[4][2], B0[2][2], B1[2][2];
    unsigned vc[2][2]; int ridx[2][2];
#define PG8_RIDX(unit) do { _Pragma("unroll") for (int _h = 0; _h < 2; ++_h) _Pragma("unroll") for (int _i = 0; _i < 2; ++_i) ridx[_h][_i] = S.arow(unit, _h * HALF + RA[_i]); } while (0)
#define PG8_VC() do { _Pragma("unroll") for (int _h = 0; _h < 2; ++_h) _Pragma("unroll") for (int _i = 0; _i < 2; ++_i) vc[_h][_i] = (unsigned)ridx[_h][_i] * rowb + coffA[_i]; } while (0)
    PG8_RIDX(cur); PG8_VC();
    const char* cB = (const char*)g.Bt + (size_t)cur.pn * tstep;
    PG8_STAGE(PG8_SB(0, 0), cB, voffB); PG8_STAGE(PG8_SB(0, 1), cB + hstep, voffB); PG8_STAGE(PG8_SA(0, 0), gA, vc[0]); PG8_STAGE(PG8_SA(0, 1), gA, vc[1]);
    if (wr == 1) PG8_BAR;
    PG8_WAIT_V(2); PG8_BAR;
    PG8_STAGE(PG8_SB(1, 0), cB + kstep, voffB); PG8_STAGE(PG8_SA(1, 0), gA + kstep, vc[0]); PG8_STAGE(PG8_SB(1, 1), cB + hstep + kstep, voffB);
    PG8_WAIT_V(6); PG8_BAR;
    for (;;) {
        const bool has_next = S.next(ui + 1, nxt);
        const char* nB = has_next ? (const char*)g.Bt + (size_t)nxt.pn * tstep : cB;
        if (has_next) PG8_RIDX(nxt);
#pragma unroll 1
        for (int t = 0; t < nt; t += 2) {
            const bool last = (t == nt - 2);
            const char* a1 = gA + (size_t)(t + 1) * kstep;
            const char* a2 = last ? gA : gA + (size_t)(t + 2) * kstep; const char* b2 = last ? nB : cB + (size_t)(t + 2) * kstep;
            const char* a3 = a2 + kstep; const char* b3 = b2 + kstep;
            PG8_LDB(B0, 0, 0); PG8_LDB(B1, 0, 1); PG8_SCHED; PG8_LDA(At, 0, 0); PG8_STAGE(PG8_SA(1, 1), a1, vc[1]);
            if (last) PG8_VC();
            PG8_WAIT_V(8); PG8_WAIT_L(0); PG8_BAR; PG8_MMA(0, 0, At, B0); PG8_MMA(0, 1, At, B1); PG8_BAR; PG8_SCHED;
            PG8_LDA(At, 0, 1); PG8_STAGE(PG8_SB(0, 0), b2, voffB); PG8_STAGE(PG8_SB(0, 1), b2 + hstep, voffB); PG8_STAGE(PG8_SA(0, 0), a2, vc[0]);
            PG8_WAIT_V(8); PG8_WAIT_L(0); PG8_BAR; PG8_MMA(1, 0, At, B0); PG8_MMA(1, 1, At, B1); PG8_BAR; PG8_SCHED;
            PG8_LDB(B0, 1, 0); PG8_LDB(B1, 1, 1); PG8_SCHED; PG8_LDA(At, 1, 0); PG8_STAGE(PG8_SA(0, 1), a2, vc[1]);
            PG8_WAIT_V(8); PG8_WAIT_L(0); PG8_BAR; PG8_MMA(0, 0, At, B0); PG8_MMA(0, 1, At, B1); PG8_BAR; PG8_SCHED;
            PG8_LDA(At, 1, 1); PG8_STAGE(PG8_SB(1, 0), b3, voffB); PG8_STAGE(PG8_SB(1, 1), b3 + hstep, voffB); PG8_STAGE(PG8_SA(1, 0), a3, vc[0]);
            PG8_WAIT_V(8); PG8_WAIT_L(0); PG8_BAR; PG8_MMA(1, 0, At, B0); PG8_MMA(1, 1, At, B1); PG8_BAR; PG8_SCHED;
        }
        if constexpr (ALIGN_EPI) { if (wr == 0) PG8_BAR; }
        E(acc, cur, wr, wc, fr, fq);
        if (!has_next) break;
#pragma unroll
        for (int a = 0; a < 2; ++a)
#pragma unroll
            for (int b = 0; b < 2; ++b)
#pragma unroll
                for (int m = 0; m < 4; ++m)
#pragma unroll
                    for (int n = 0; n < 2; ++n) acc[a][b][m][n] = (f32x4){0.f, 0.f, 0.f, 0.f};
        cur = nxt; cB = nB; ++ui;
        if constexpr (ALIGN_EPI) { if (wr == 1) PG8_BAR; }
    }
    PG8_WAIT_V(0);
    if constexpr (!ALIGN_EPI) { if (wr == 0) PG8_BAR; }
    PG8_BAR;
#undef PG8_SA
#undef PG8_SB
#undef PG8_STAGE
#undef PG8_RIDX
#undef PG8_VC
#undef PG8_LDA
#undef PG8_LDB
#undef PG8_MMA
#undef PG8_WAIT_V
#undef PG8_WAIT_L
#undef PG8_BAR
#undef PG8_SCHED
}
}

constexpr int NWAVES = 8, NTHR = NWAVES * 64;
constexpr int BATCH = 16, SEQ = 2048, D = 2048, M = BATCH * SEQ;
constexpr int RW = 1024, RH = 64, RHEADS = 16, DEC_R = 64, AAA_R = 64, GATE_R = 160, LORA = DEC_R + AAA_R + GATE_R;
constexpr int RCOLS = 3 * RW + LORA;
constexpr int S5W = 1024, S5G = 16, S5NG = 64, S5P = 64;
constexpr int IN_COLS = RCOLS + S5W + 2 * D;
constexpr int NPROJ = 8704;
constexpr int PRW = 3584;
constexpr int NEXP = 32, DEXP = 512, CAP = 32768;
constexpr int MAXTILES = 288;
constexpr float RMS_EPS = 1e-6f, GN_EPS = 64e-5f;

constexpr size_t MiB = 1u << 20;
constexpr size_t WS_CTL = 0, CTL_ZERO_BYTES = 65536;
constexpr size_t WS_TOKI = 1 * MiB;
constexpr size_t WS_TOKW = 1 * MiB + 512 * 1024;
constexpr size_t WS_LIST = 2 * MiB;
constexpr size_t WS_WIN = 8 * MiB;
constexpr size_t WS_WINU8 = 20 * MiB;
constexpr size_t WS_WIN8 = 26 * MiB;
constexpr size_t WS_WGL = 42 * MiB;
constexpr size_t WS_WO = 50 * MiB;
constexpr size_t WS_WRO = 58 * MiB;
constexpr size_t WS_RT = 62 * MiB;
constexpr size_t WS_LORA = 63 * MiB;
constexpr size_t WS_MGU = 64 * MiB;
constexpr size_t WS_MD = 192 * MiB;
constexpr size_t WS_A = 256 * MiB;
constexpr size_t WS_B = 384 * MiB;
constexpr size_t WS_C = 672 * MiB;
constexpr size_t WS_LIN = 928 * MiB;
constexpr size_t WS_H28 = 947 * MiB;
constexpr size_t WS_END = 1011 * MiB;
constexpr size_t WS_H = WS_A, WS_YA = WS_A, WS_Z = WS_A + 64 * MiB;
constexpr size_t WS_PR = WS_B, WS_U = WS_B + 224 * MiB, WS_MIX = WS_B, WS_Y2 = WS_B;
constexpr size_t WS_YAO = WS_C, WS_YBO = WS_C + 128 * MiB;
constexpr size_t WS_HID = WS_C, WS_X1 = WS_C + 64 * MiB;
constexpr int CW_BAR = 4096;
constexpr int CW_CNT = 8192;

constexpr int LDSCTL_OFF = 0, MISC_OFF = 320, RING_OFF = 512, LDS_BYTES = 163840, RING_BYTES = LDS_BYTES - RING_OFF;

#define GAS __attribute__((address_space(1)))
#define LAS __attribute__((address_space(3)))
typedef unsigned short bf16;
typedef unsigned v4u __attribute__((ext_vector_type(4)));
typedef unsigned v2u __attribute__((ext_vector_type(2)));
typedef float f32x4 __attribute__((ext_vector_type(4)));
typedef float f32x16 __attribute__((ext_vector_type(16)));
typedef short bf16x8 __attribute__((ext_vector_type(8)));
#define LDS_WAIT() asm volatile("s_waitcnt lgkmcnt(0)" ::: "memory")
#define VM_WAIT() asm volatile("s_waitcnt vmcnt(0)" ::: "memory")
#define LDS_ORDER() asm volatile("" ::: "memory")
__device__ __forceinline__ unsigned f2bf(float f) { unsigned u = __builtin_bit_cast(unsigned, f); return (u + 0x7fffu + ((u >> 16) & 1u)) >> 16; }
__device__ __forceinline__ unsigned pk2(float lo, float hi) { return f2bf(lo) | (f2bf(hi) << 16); }
__device__ __forceinline__ float bflo(unsigned w) { return __builtin_bit_cast(float, w << 16); }
__device__ __forceinline__ float bfhi(unsigned w) { return __builtin_bit_cast(float, w & 0xffff0000u); }
__device__ __forceinline__ float bf2f(bf16 b) { return __builtin_bit_cast(float, ((unsigned)b) << 16); }
__device__ __forceinline__ float sigmoidf_(float x) { return __builtin_amdgcn_rcpf(1.0f + __expf(-x)); }
__device__ __forceinline__ float wave_sum(float v) {
#pragma unroll
    for (int o = 1; o < 64; o <<= 1) v += __shfl_xor(v, o);
    return v;
}

#define XB_TMO      128
#define XB_XCNT(j)  (256  + 64 * (j))
#define XB_XSUB(j)  (1280 + 64 * (j))
#define XB_XGEN(j)  (2304 + 64 * (j))
#define XB_TOP      3328
#define XB_TOPGEN   3392
#define XCD_BAR_WORDS 3456
#define XB_SPIN_CAP (1u << 18)

__device__ __forceinline__ unsigned xb_ld(unsigned* p)              { return __hip_atomic_load(p, __ATOMIC_RELAXED, __HIP_MEMORY_SCOPE_AGENT); }
__device__ __forceinline__ unsigned xb_add(unsigned* p, unsigned v) { return __hip_atomic_fetch_add(p, v, __ATOMIC_RELAXED, __HIP_MEMORY_SCOPE_AGENT); }
__device__ __forceinline__ unsigned xb_xcc_id() { return (unsigned)__builtin_amdgcn_s_getreg((3 << 11) | 20) & 0xFu; }
#define XB_SPIN(cond, bar) do { unsigned _sp = 0; while (cond) { __builtin_amdgcn_s_sleep(1); \
    if ((++_sp & 255u) == 0u) { if (xb_ld(&(bar)[XB_TMO])) break; if (_sp > XB_SPIN_CAP) { atomicAdd(&(bar)[XB_TMO], 1u); break; } } } } while (0)

struct XcdBarrier {
    unsigned* bar; unsigned x;
    volatile LAS unsigned* st;
};

__device__ __forceinline__ XcdBarrier xcd_barrier_post(unsigned* bar, volatile LAS unsigned* st) {
    XcdBarrier b; b.bar = bar; b.x = xb_xcc_id(); b.st = st;
    if (threadIdx.x == 0) (void)xb_add(&bar[XB_XCNT(b.x)], 1u);
    return b;
}
__device__ __forceinline__ void xcd_barrier_complete(unsigned* bar, unsigned x, unsigned& nloc, unsigned& nx) {
    const unsigned G = gridDim.x * gridDim.y * gridDim.z;
    unsigned sum, cnt, mine, sp = 0u;
    for (;;) {
        sum = 0u; cnt = 0u; mine = 0u;
#pragma unroll
        for (unsigned j = 0; j < 16; ++j) { const unsigned c = xb_ld(&bar[XB_XCNT(j)]); sum += c; cnt += (c > 0u) ? 1u : 0u; mine = (j == x) ? c : mine; }
        if (sum == G) break;
        __builtin_amdgcn_s_sleep(1);
        if ((++sp & 255u) == 0u) { if (xb_ld(&bar[XB_TMO])) break; if (sp > XB_SPIN_CAP) { atomicAdd(&bar[XB_TMO], 1u); break; } }
    }
    nloc = mine > 0u ? mine : 1u; nx = cnt > 0u ? cnt : 1u;
}

__device__ __forceinline__ void xcd_barrier(const XcdBarrier& b) {
    asm volatile("s_waitcnt vmcnt(0)" ::: "memory");
    __syncthreads();
    if (threadIdx.x == 0) {
        unsigned* bar = b.bar;
        __builtin_amdgcn_s_waitcnt(0);
        unsigned nloc = b.st[0], nx = b.st[1];
        if (nloc == 0u) { xcd_barrier_complete(bar, b.x, nloc, nx); b.st[0] = nloc; b.st[1] = nx; }
        const unsigned old = xb_add(&bar[XB_XSUB(b.x)], 1u);
        const unsigned gen = old / nloc;
        if (old + 1u == (gen + 1u) * nloc) {
            __builtin_amdgcn_fence(__ATOMIC_RELEASE, "agent");
            asm volatile("s_waitcnt vmcnt(0)" ::: "memory");
            const unsigned og = xb_add(&bar[XB_TOP], 1u);
            const unsigned tg = og / nx;
            if (og + 1u == (tg + 1u) * nx) xb_add(&bar[XB_TOPGEN], 1u);
            else XB_SPIN(xb_ld(&bar[XB_TOPGEN]) == tg, bar);
            __builtin_amdgcn_fence(__ATOMIC_ACQUIRE, "agent");
            xb_add(&bar[XB_XGEN(b.x)], 1u);
            asm volatile("s_waitcnt vmcnt(0)" ::: "memory");
        } else {
            XB_SPIN(xb_ld(&bar[XB_XGEN(b.x)]) == gen, bar);
            __builtin_amdgcn_fence(__ATOMIC_ACQUIRE, "agent");
            asm volatile("s_waitcnt vmcnt(0)" ::: "memory");
        }
    }
    __syncthreads();
}


constexpr int MOE_WGU_SH = 6, MOE_WD_SH = 5, MOE_HID_SH = 2, GLU_W_SH = 5, GLU_Z_SH = 2, Y2_SH = 4, WO_W_SH = 6, MIX_SH = 2;
__device__ __forceinline__ unsigned pk4_fp8(float a, float b, float c, float d) {
    a = __builtin_fminf(__builtin_fmaxf(a, -448.f), 448.f); b = __builtin_fminf(__builtin_fmaxf(b, -448.f), 448.f); c = __builtin_fminf(__builtin_fmaxf(c, -448.f), 448.f); d = __builtin_fminf(__builtin_fmaxf(d, -448.f), 448.f);
    int v = __builtin_amdgcn_cvt_pk_fp8_f32(a, b, 0, false); v = __builtin_amdgcn_cvt_pk_fp8_f32(c, d, v, true); return (unsigned)v; }

__device__ __forceinline__ void unpack8(const v4u w, float (&o)[8]) { o[0] = bflo(w.x); o[1] = bfhi(w.x); o[2] = bflo(w.y); o[3] = bfhi(w.y); o[4] = bflo(w.z); o[5] = bfhi(w.z); o[6] = bflo(w.w); o[7] = bfhi(w.w); }
__device__ __forceinline__ v4u pack8(const float (&o)[8]) { v4u w; w.x = pg8::cvt_pk_bf16(o[0], o[1]); w.y = pg8::cvt_pk_bf16(o[2], o[3]); w.z = pg8::cvt_pk_bf16(o[4], o[5]); w.w = pg8::cvt_pk_bf16(o[6], o[7]); return w; }
__device__ __forceinline__ void st_fp8_rowpair(unsigned char* pa, size_t rb_off, v2u a, v2u b, int fq) {
    const auto r0 = __builtin_amdgcn_permlane16_swap(a.x, b.x, false, false), r1 = __builtin_amdgcn_permlane16_swap(a.y, b.y, false, false);
    v4u w; w.x = r0[0]; w.y = r1[0]; w.z = r0[1]; w.w = r1[1];
    *(v4u*)((fq & 1) ? pa + rb_off - 8 : pa) = w;
}
using pg8::Unit;
struct EpiProj {
    static constexpr bool PERM = true;
    bf16 *PR, *U; int pn0;
    __device__ __forceinline__ void operator()(const f32x4 (&acc)[2][2][4][2], const Unit& u, int wr, int wc, int fr, int fq) const {
        const int row0 = u.pm * 256 + wr * 64 + fr, pn = u.pn + pn0;
        const int kind = pn < 12 ? 0 : (pn < 14 ? 1 : 2);
        const int colt = kind == 0 ? pn * 256 : (kind == 1 ? (pn - 12) * 256 : (pn - 14) * 256);
#pragma unroll
        for (int ai = 0; ai < 2; ++ai)
#pragma unroll
            for (int m = 0; m < 4; ++m) { const int row = row0 + ai * 128 + m * 16, bb = row >> 11, tt = row & (SEQ - 1);
#pragma unroll
                for (int bj = 0; bj < 2; ++bj) { f32x4 v0 = acc[ai][bj][m][0], v1 = acc[ai][bj][m][1];
                    const int c = colt + bj * 128 + wc * 32 + 8 * fq; bf16* dst;
                    if (kind == 0) { const int a = c >> 10, hd = (c >> 6) & 15, cc = c & 63; dst = PR + ((((size_t)(bb * RHEADS + hd) * SEQ + tt) * 3 + a) * 64 + cc); }
                    else if (kind == 1) dst = PR + (size_t)M * (3 * RW) + (size_t)row * 512 + c;
                    else { const int gg = c >> 4, cc = c & 15; dst = U + (((size_t)(bb * S5NG + gg) * SEQ + tt) * 16 + cc); }
                    v4u w; w.x = pg8::cvt_pk_bf16(v0[0], v0[1]); w.y = pg8::cvt_pk_bf16(v0[2], v0[3]); w.z = pg8::cvt_pk_bf16(v1[0], v1[1]); w.w = pg8::cvt_pk_bf16(v1[2], v1[3]);
                    *(v4u*)dst = w; } }
    }
};
struct EpiYa {
    static constexpr bool PERM = true;
    bf16* O;
    __device__ __forceinline__ void operator()(const f32x4 (&acc)[2][2][4][2], const Unit& u, int wr, int wc, int fr, int fq) const {
        const int row0 = u.pm * 256 + wr * 64 + fr, col0 = u.pn * 256 + wc * 32 + 8 * fq;
#pragma unroll
        for (int ai = 0; ai < 2; ++ai)
#pragma unroll
            for (int m = 0; m < 4; ++m) { const size_t row = (size_t)(row0 + ai * 128 + m * 16);
#pragma unroll
                for (int bj = 0; bj < 2; ++bj) { const f32x4 v0 = acc[ai][bj][m][0], v1 = acc[ai][bj][m][1];
                    v4u w; w.x = pg8::cvt_pk_bf16(v0[0], v0[1]); w.y = pg8::cvt_pk_bf16(v0[2], v0[3]); w.z = pg8::cvt_pk_bf16(v1[0], v1[1]); w.w = pg8::cvt_pk_bf16(v1[2], v1[3]);
                    *(v4u*)(O + row * D + col0 + bj * 128) = w; } }
    }
};
struct EpiGlu {
    static constexpr bool PERM = true;
    bf16* O;
    __device__ __forceinline__ void operator()(const f32x4 (&acc)[2][2][4][2], const Unit& u, int wr, int wc, int fr, int fq) const {
        const int row0 = u.pm * 256 + wr * 64 + fr, col0 = u.pn * 128 + wc * 32 + 8 * fq;
#pragma unroll
        for (int ai = 0; ai < 2; ++ai)
#pragma unroll
            for (int m = 0; m < 4; ++m) { const size_t row = (size_t)(row0 + ai * 128 + m * 16);
                float o[8];
#pragma unroll
                for (int n = 0; n < 2; ++n)
#pragma unroll
                    for (int j = 0; j < 4; ++j) o[n * 4 + j] = acc[ai][0][m][n][j] * sigmoidf_(acc[ai][1][m][n][j]);
                *(v4u*)(O + row * D + col0) = pack8(o); }
    }
};
struct EpiMerge {
    static constexpr bool PERM = true;
    const bf16 *YA, *YB; unsigned char* MIX;
    __device__ __forceinline__ void operator()(const f32x4 (&acc)[2][2][4][2], const Unit& u, int wr, int wc, int fr, int fq) const {
        const int row0 = u.pm * 256 + wr * 64 + fr, col0 = u.pn * 128 + wc * 32 + 8 * fq;
#pragma unroll
        for (int ai = 0; ai < 2; ++ai)
#pragma unroll
            for (int mp = 0; mp < 4; mp += 2) { v2u w2[2];
#pragma unroll
                for (int mm = 0; mm < 2; ++mm) { const int m = mp + mm; const size_t off = (size_t)(row0 + ai * 128 + m * 16) * D + col0;
                    float a8[8], b8[8], o[8]; unpack8(*(const v4u*)(YA + off), a8); unpack8(*(const v4u*)(YB + off), b8);
#pragma unroll
                    for (int n = 0; n < 2; ++n)
#pragma unroll
                        for (int j = 0; j < 4; ++j) o[n * 4 + j] = sigmoidf_(acc[ai][0][m][n][j]) * a8[n * 4 + j] + sigmoidf_(acc[ai][1][m][n][j]) * b8[n * 4 + j];
                    constexpr float ms = (float)(1 << MIX_SH);
                    w2[mm] = (v2u){pk4_fp8(o[0] * ms, o[1] * ms, o[2] * ms, o[3] * ms), pk4_fp8(o[4] * ms, o[5] * ms, o[6] * ms, o[7] * ms)}; }
                st_fp8_rowpair(MIX + (size_t)(row0 + ai * 128 + mp * 16) * D + col0, (size_t)16 * D, w2[0], w2[1], fq); }
    }
};
struct EpiX1 {
    static constexpr bool PERM = true;
    const float* X; bf16* O;
    __device__ __forceinline__ void operator()(const f32x4 (&acc)[2][2][4][2], const Unit& u, int wr, int wc, int fr, int fq) const {
        const int row0 = u.pm * 256 + wr * 64 + fr, col0 = u.pn * 256 + wc * 32 + 8 * fq;
#pragma unroll
        for (int ai = 0; ai < 2; ++ai) {
            f32x4 xv[4][2][2];
#pragma unroll
            for (int m = 0; m < 4; ++m) { const size_t off = (size_t)(row0 + ai * 128 + m * 16) * D + col0;
#pragma unroll
                for (int bj = 0; bj < 2; ++bj) { xv[m][bj][0] = *(const f32x4*)(X + off + bj * 128); xv[m][bj][1] = *(const f32x4*)(X + off + bj * 128 + 4); } }
#pragma unroll
            for (int m = 0; m < 4; ++m) { const size_t off = (size_t)(row0 + ai * 128 + m * 16) * D + col0;
#pragma unroll
                for (int bj = 0; bj < 2; ++bj) { const f32x4 v0 = xv[m][bj][0] + acc[ai][bj][m][0], v1 = xv[m][bj][1] + acc[ai][bj][m][1];
                    v4u w; w.x = pg8::cvt_pk_bf16(v0[0], v0[1]); w.y = pg8::cvt_pk_bf16(v0[2], v0[3]); w.z = pg8::cvt_pk_bf16(v1[0], v1[1]); w.w = pg8::cvt_pk_bf16(v1[2], v1[3]);
                    *(v4u*)(O + off + bj * 128) = w; } } }
    }
};
struct EpiMoeGU {
    static constexpr bool PERM = true;
    unsigned char* HID;
    __device__ __forceinline__ void operator()(const f32x4 (&acc)[2][2][4][2], const Unit& u, int wr, int wc, int fr, int fq) const {
        const int row0 = u.pm * 256 + wr * 64 + fr, col0 = (u.pn & 3) * 128 + wc * 32 + 8 * fq;
#pragma unroll
        for (int ai = 0; ai < 2; ++ai)
#pragma unroll
            for (int mp = 0; mp < 4; mp += 2) { v2u w2[2];
#pragma unroll
                for (int mm = 0; mm < 2; ++mm) { const int m = mp + mm; float o[8];
#pragma unroll
                    for (int n = 0; n < 2; ++n)
#pragma unroll
                        for (int j = 0; j < 4; ++j) { const float gt = acc[ai][0][m][n][j]; o[n * 4 + j] = gt * sigmoidf_(gt) * acc[ai][1][m][n][j] * (float)(1 << MOE_HID_SH); }
                    w2[mm].x = pk4_fp8(o[0], o[1], o[2], o[3]); w2[mm].y = pk4_fp8(o[4], o[5], o[6], o[7]); }
                st_fp8_rowpair(HID + (size_t)(row0 + ai * 128 + mp * 16) * DEXP + col0, (size_t)16 * DEXP, w2[0], w2[1], fq); }
    }
};
struct EpiMoeDown {
    static constexpr bool PERM = true;
    unsigned char* Y2;
    __device__ __forceinline__ void operator()(const f32x4 (&acc)[2][2][4][2], const Unit& u, int wr, int wc, int fr, int fq) const {
        const int row0 = u.pm * 256 + wr * 64 + fr, col0 = (u.pn & 7) * 256 + wc * 32 + 8 * fq; constexpr float ys = (float)(1 << Y2_SH);
#pragma unroll
        for (int ai = 0; ai < 2; ++ai)
#pragma unroll
            for (int mp = 0; mp < 4; mp += 2) { unsigned char* rowp = Y2 + (size_t)(row0 + ai * 128 + mp * 16) * D + col0;
#pragma unroll
                for (int bj = 0; bj < 2; ++bj) { v2u w2[2];
#pragma unroll
                    for (int mm = 0; mm < 2; ++mm) { const f32x4 v0 = acc[ai][bj][mp + mm][0] * ys, v1 = acc[ai][bj][mp + mm][1] * ys;
                        w2[mm].x = pk4_fp8(v0[0], v0[1], v0[2], v0[3]); w2[mm].y = pk4_fp8(v1[0], v1[1], v1[2], v1[3]); }
                    st_fp8_rowpair(rowp + bj * 128, (size_t)16 * D, w2[0], w2[1], fq); } }
    }
};
struct MoeOrder {
    const LAS int* tb; const LAS int* cntl; const int* list; int ncol, G, c; bool gather;
    __device__ __forceinline__ bool next(int i, Unit& u) const {
        const int L = i * G + c, total = tb[NEXP] * ncol; if (L >= total) return false;
        const int tr = L / ncol, j = L - tr * ncol; int e = 0;
        for (int k = 1; k < NEXP; ++k) e += (tb[k] <= tr) ? 1 : 0;
        u.pm = tr; u.pn = e * ncol + j; u.e = e; u.rt = tr - tb[e]; return true;
    }
    __device__ __forceinline__ int arow(const Unit& u, int r) const {
        if (!gather) return u.pm * 256 + r;
        const int pos = u.rt * 256 + r; return pos < cntl[u.e] ? list[(size_t)u.e * CAP + pos] : 0;
    }
};

struct Params { const float* in[35]; float* out; unsigned char* ws; int ph_lo, ph_hi; };
enum { I_X = 0, I_NMG, I_WIN, I_MU, I_W0, I_WUP, I_A0, I_AUP, I_GUP, I_KK, I_KA, I_RK, I_LNW, I_LNB, I_RWO, I_LRE, I_LIM, I_LSTEP, I_BRE, I_BIM, I_CRE, I_CIM, I_SD, I_GLV, I_GLG, I_WOUT, I_NFG,
       I_RGW, I_RGB, I_REW, I_REB, I_MG, I_MU2, I_MDN, I_NFIN };

struct CvtItem { const float* W; int N, k0, n0, dK, fp8; void* dst; size_t drow0; float scale; };
__device__ __forceinline__ void cvt_load(const CvtItem& d, float (&r)[32], int lane) {
#pragma unroll
    for (int i = 0; i < 32; ++i) r[i] = d.W[(size_t)(d.k0 + 2 * i + (lane >> 5)) * d.N + d.n0 + (lane & 31)];
}
__device__ __forceinline__ void cvt_store(const CvtItem& d, const float (&r)[32], LAS float* scr, int lane) {
#pragma unroll
    for (int i = 0; i < 32; ++i) scr[(2 * i + (lane >> 5)) * 33 + (lane & 31)] = r[i] * d.scale;
    LDS_ORDER();
    if (d.fp8) { const int c = lane & 3;
#pragma unroll
        for (int j = 0; j < 2; ++j) { const int n = (lane >> 2) + 16 * j; const LAS float* s = scr + (16 * c) * 33 + n;
            v4u o; o.x = pk4_fp8(s[0 * 33], s[1 * 33], s[2 * 33], s[3 * 33]); o.y = pk4_fp8(s[4 * 33], s[5 * 33], s[6 * 33], s[7 * 33]);
            o.z = pk4_fp8(s[8 * 33], s[9 * 33], s[10 * 33], s[11 * 33]); o.w = pk4_fp8(s[12 * 33], s[13 * 33], s[14 * 33], s[15 * 33]);
            *(v4u*)((unsigned char*)d.dst + (d.drow0 + n) * d.dK + d.k0 + 16 * c) = o; } }
    else { const int c = lane & 7;
#pragma unroll
        for (int j = 0; j < 4; ++j) { const int n = (lane >> 3) + 8 * j; const LAS float* s = scr + (8 * c) * 33 + n;
            v4u o; o.x = pk2(s[0 * 33], s[1 * 33]); o.y = pk2(s[2 * 33], s[3 * 33]); o.z = pk2(s[4 * 33], s[5 * 33]); o.w = pk2(s[6 * 33], s[7 * 33]);
            *(v4u*)((bf16*)d.dst + (d.drow0 + n) * d.dK + d.k0 + 8 * c) = o; } }
    LDS_ORDER();
}
template <class DescFn> __device__ __forceinline__ void cvt_run(const DescFn& desc, int it0, int nitems, int stride, LAS float* scr, int lane) {
    if (it0 >= nitems) return;
    float ra[32], rb[32]; CvtItem da = desc(it0), db = da; cvt_load(da, ra, lane);
    for (int it = it0; it < nitems; it += 2 * stride) {
        const int i1 = it + stride, i2 = it + 2 * stride;
        if (i1 < nitems) { db = desc(i1); cvt_load(db, rb, lane); }
        cvt_store(da, ra, scr, lane);
        if (i2 < nitems) { da = desc(i2); cvt_load(da, ra, lane); }
        if (i1 < nitems) cvt_store(db, rb, scr, lane);
    }
}
struct P2Desc { const Params* p;
    __device__ __forceinline__ CvtItem operator()(int it) const { constexpr int I5 = 32 * 512, I6 = 32 * 512, I7 = 32 * 512, I1 = 16 * 64, I2 = 16 * 64, I3 = 16 * 64, I4 = 32 * 64; unsigned char* ws = p->ws; int r = it;
        if (r < I5 + I6) { const int up = r >= I5 ? 1 : 0; if (up) r -= I5; const int e = r / 512, q = r % 512, kb = q / 16, nb = q % 16, n0 = nb * 32;
            return CvtItem{p->in[up ? I_MU2 : I_MG] + (size_t)e * D * DEXP, DEXP, kb * 64, n0, D, 1, ws + WS_MGU, (size_t)e * 1024 + (n0 >> 7) * 256 + up * 128 + (n0 & 127), (float)(1 << MOE_WGU_SH)}; } r -= I5 + I6;
        if (r < I7) { const int e = r / 512, q = r % 512, kb = q / 64, nb = q % 64;
            return CvtItem{p->in[I_MDN] + (size_t)e * DEXP * D, D, kb * 64, nb * 32, DEXP, 1, ws + WS_MD, (size_t)e * D + nb * 32, (float)(1 << MOE_WD_SH)}; } r -= I7;
        if (r < I1) { const int kb = r / 64, nb = r % 64; return CvtItem{p->in[I_RWO], D, kb * 64, nb * 32, RW, 0, ws + WS_WRO, (size_t)(nb * 32), 1.0f}; } r -= I1;
        if (r < I2) { const int kb = r / 64, nb = r % 64, n0 = nb * 32; return CvtItem{p->in[I_GLV], D, kb * 64, n0, S5W, 1, ws + WS_WGL, (size_t)((n0 >> 7) * 256 + (n0 & 127)), (float)(1 << GLU_W_SH)}; } r -= I2;
        if (r < I3) { const int kb = r / 64, nb = r % 64, n0 = nb * 32; return CvtItem{p->in[I_GLG], D, kb * 64, n0, S5W, 1, ws + WS_WGL, (size_t)((n0 >> 7) * 256 + 128 + (n0 & 127)), (float)(1 << GLU_W_SH)}; } r -= I3;
        if (r < I4) { const int kb = r / 64, nb = r % 64; return CvtItem{p->in[I_WOUT], D, kb * 64, nb * 32, D, 1, ws + WS_WO, (size_t)(nb * 32), (float)(1 << WO_W_SH)}; } r -= I4;
        return CvtItem{p->in[I_REW], 32, r * 64, 0, D, 0, ws + WS_RT, (size_t)4, 1.0f}; } };
constexpr int P2_ITEMS = 3 * 32 * 512 + 3 * 16 * 64 + 32 * 64 + 32;
__device__ __forceinline__ void p2_convert(const Params& p, LAS float* scr, int gw4, int NGW4, int lane) {
    P2Desc pd{&p}; cvt_run(pd, gw4, P2_ITEMS, NGW4, scr, lane);
    unsigned char* ws = p.ws; const size_t gt = (size_t)gw4 * 64 + lane, nth = (size_t)NGW4 * 64;
    v4u z; z.x = 0u; z.y = 0u; z.z = 0u; z.w = 0u;
    v4u* r0 = (v4u*)(ws + WS_RT + (size_t)36 * D * 2); for (size_t i = gt; i < (size_t)(256 - 36) * D / 8; i += nth) r0[i] = z;
    bf16* rt = (bf16*)(ws + WS_RT); for (size_t i = gt; i < (size_t)4 * D; i += nth) { const int n = (int)(i / D), k = (int)(i % D); rt[i] = (bf16)f2bf(p.in[I_RGW][k * 4 + n]); }
    bf16* wut = (bf16*)(ws + WS_LORA); bf16* aut = wut + RW * 64; bf16* gut = aut + RW * 64;
    for (size_t i = gt; i < (size_t)RW * 64; i += nth) { const int c = (int)(i >> 6), k = (int)(i & 63); wut[i] = (bf16)f2bf(p.in[I_WUP][(size_t)k * RW + c]); aut[i] = (bf16)f2bf(p.in[I_AUP][(size_t)k * RW + c]); }
    for (size_t i = gt; i < (size_t)RW * 160; i += nth) { const int c = (int)(i / 160), k = (int)(i % 160); gut[i] = (bf16)f2bf(p.in[I_GUP][(size_t)k * RW + c]); }
}
struct P0Desc { const Params* p;
    __device__ __forceinline__ CvtItem operator()(int it) const { unsigned char* ws = p->ws; const int kb = it / 265, nb = it % 265, n0 = nb * 32;
        if (n0 >= RCOLS + S5W) { const int gc = n0 - RCOLS - S5W, isb = gc >= D ? 1 : 0, c = gc - isb * D;
            return CvtItem{p->in[I_WIN], IN_COLS, kb * 64, n0, D, 1, ws + WS_WIN8, (size_t)((c >> 7) * 256 + isb * 128 + (c & 127)), (float)(1 << MOE_WGU_SH)}; }
        if (n0 >= RCOLS) return CvtItem{p->in[I_WIN], IN_COLS, kb * 64, n0, D, 1, ws + WS_WINU8, (size_t)(512 + n0 - RCOLS), (float)(1 << MOE_WGU_SH)};
        if (n0 >= 3 * RW) return CvtItem{p->in[I_WIN], IN_COLS, kb * 64, n0, D, 1, ws + WS_WINU8, (size_t)(n0 - 3 * RW), (float)(1 << MOE_WGU_SH)};
        return CvtItem{p->in[I_WIN], IN_COLS, kb * 64, n0, D, 0, ws + WS_WIN, (size_t)n0, 1.0f}; } };
__device__ __forceinline__ void p0_prologue(const Params& p, LAS unsigned char* lds, int gw, int NGW, int wave, int lane) {
    LAS float* scr = (LAS float*)(lds + wave * 16384);
    unsigned char* ws = p.ws;
    { P0Desc pd{&p}; cvt_run(pd, gw, 32 * 265, NGW, scr, lane); }
    { const size_t gt = (size_t)gw * 64 + lane, nth = (size_t)NGW * 64;
      v4u z; z.x = 0u; z.y = 0u; z.z = 0u; z.w = 0u;
      v4u* w0 = (v4u*)(ws + WS_WINU8 + (size_t)LORA * D); for (size_t i = gt; i < (size_t)(512 - LORA) * D / 16; i += nth) w0[i] = z; }
    bf16* H = (bf16*)(ws + WS_H);
    {
        f32x4 g[8], v[8], vn[8];
#pragma unroll
        for (int j = 0; j < 8; ++j) g[j] = ((const f32x4*)p.in[I_NMG] + lane)[64 * j];
        if (gw < M) {
#pragma unroll
            for (int j = 0; j < 8; ++j) v[j] = ((const f32x4*)(p.in[I_X] + (size_t)gw * D) + lane)[64 * j]; }
        for (int m = gw; m < M; m += NGW) {
            const int mn = m + NGW < M ? m + NGW : m;
#pragma unroll
            for (int j = 0; j < 8; ++j) vn[j] = ((const f32x4*)(p.in[I_X] + (size_t)mn * D) + lane)[64 * j];
            float s = 0.f;
#pragma unroll
            for (int j = 0; j < 8; ++j) s += (v[j].x * v[j].x + v[j].y * v[j].y) + (v[j].z * v[j].z + v[j].w * v[j].w);
            const float rs = 1.0f / sqrtf(wave_sum(s) * (1.f / D) + RMS_EPS);
            v2u* o8 = (v2u*)(H + (size_t)m * D) + lane; unsigned* o4 = (unsigned*)(ws + WS_H28 + (size_t)m * D) + lane;
#pragma unroll
            for (int j = 0; j < 8; ++j) { const f32x4 y = v[j] * rs * g[j]; v2u w; w.x = pk2(y.x, y.y); w.y = pk2(y.z, y.w); o8[64 * j] = w; o4[64 * j] = pk4_fp8(y.x, y.y, y.z, y.w); }
#pragma unroll
            for (int j = 0; j < 8; ++j) v[j] = vn[j];
        }
    }
}

typedef short s16x4 __attribute__((ext_vector_type(4)));
constexpr int CP = 68;
constexpr int SL_AT = 0, SL_RT = 16 * CP * 2, SL_BT = 2 * SL_RT, SL_KT = 3 * SL_RT, SL_VT = 4 * SL_RT;
constexpr int SL_GAK = 5 * SL_RT, SL_GRK = SL_GAK + 512, SL_TT = SL_GRK + 512, SL_GT = SL_TT + 512, SL_PL = SL_GT + 512, SLOT_BYTES = SL_PL + 256;
constexpr int YB_OFF = 8 * SLOT_BYTES, YB_CHUNK = 16 * 64 * 2;
constexpr int PRM_OFF = YB_OFF + 8 * YB_CHUNK;
constexpr int LW_OFF = PRM_OFF + 10 * 64 * 4;
constexpr int BON_OFF = LW_OFF + 36 * 1024;
static_assert(BON_OFF + 8 * 64 <= RING_BYTES, "rwkv LDS");
template <int CTRL> __device__ __forceinline__ float dpp_mov0(float v) { return __builtin_bit_cast(float, __builtin_amdgcn_update_dpp(0, __builtin_bit_cast(int, v), CTRL, 0xf, 0xf, false)); }
template <int CTRL> __device__ __forceinline__ float dpp_mov1(float v) { return __builtin_bit_cast(float, __builtin_amdgcn_update_dpp(0x3f800000, __builtin_bit_cast(int, v), CTRL, 0xf, 0xf, false)); }
__device__ __forceinline__ float row_scanmul16(float v) { v *= dpp_mov1<0x111>(v); v *= dpp_mov1<0x112>(v); v *= dpp_mov1<0x114>(v); v *= dpp_mov1<0x118>(v); return v; }
__device__ __forceinline__ float row_scan16(float v) { v += dpp_mov0<0x111>(v); v += dpp_mov0<0x112>(v); v += dpp_mov0<0x114>(v); v += dpp_mov0<0x118>(v); return v; }
__device__ __forceinline__ s16x4 pack4(const f32x4 v) { v2u w; w.x = pg8::cvt_pk_bf16(v[0], v[1]); w.y = pg8::cvt_pk_bf16(v[2], v[3]); return __builtin_bit_cast(s16x4, w); }
__device__ __forceinline__ f32x4 mm16(const f32x4 aT, const f32x4 b) { return __builtin_amdgcn_mfma_f32_16x16x16bf16_1k(pack4(aT), pack4(b), (f32x4){0.f, 0.f, 0.f, 0.f}, 0, 0, 0); }
__device__ __forceinline__ bf16x8 cat8(const s16x4 a, const s16x4 b) { return (bf16x8){a[0], a[1], a[2], a[3], b[0], b[1], b[2], b[3]}; }
__device__ __forceinline__ float tanh_fast(float x) { return 1.0f - 2.0f * __builtin_amdgcn_rcpf(1.0f + __expf(2.0f * x)); }
__device__ __forceinline__ void st16(LAS unsigned char* a, const v4u w) { *(LAS v2u*)a = (v2u){w.x, w.y}; *(LAS v2u*)(a + 8) = (v2u){w.z, w.w}; }


__device__ __forceinline__ void rwkv_stage(const Params& p, int h, LAS unsigned char* lds, int tid) {
    LAS float* PRM = (LAS float*)(lds + PRM_OFF);
    for (int i = tid; i < 640; i += NTHR) { const int idx = i >> 6, c = h * 64 + (i & 63); float v;
        switch (idx) { case 0: v = p.in[I_W0][c]; break; case 1: v = p.in[I_A0][c]; break; case 2: v = p.in[I_KK][c]; break; case 3: v = p.in[I_KA][c]; break; case 4: v = p.in[I_RK][c]; break;
                       case 5: v = p.in[I_LNW][c]; break; case 6: v = p.in[I_LNB][c]; break; default: v = p.in[I_MU][(idx - 7) * RW + c]; break; }
        PRM[i] = v; }
    const bf16* WUT = (const bf16*)(p.ws + WS_LORA); const bf16* AUT = WUT + RW * 64; const bf16* GUT = AUT + RW * 64;
    for (int i = tid; i < 36 * 64; i += NTHR) { const int f = i >> 6, l = i & 63, m = l & 15, kq = l >> 4; const bf16* src; int nt, ks;
        if (f < 8) { nt = f >> 1; ks = f & 1; src = WUT + (size_t)(h * 64 + 16 * (m >> 2) + 4 * nt + (m & 3)) * 64 + 32 * ks + 8 * kq; }
        else if (f < 16) { nt = (f - 8) >> 1; ks = f & 1; src = AUT + (size_t)(h * 64 + 16 * (m >> 2) + 4 * nt + (m & 3)) * 64 + 32 * ks + 8 * kq; }
        else { nt = (f - 16) / 5; ks = (f - 16) - 5 * nt; src = GUT + (size_t)(h * 64 + 16 * (m >> 2) + 4 * nt + (m & 3)) * 160 + 32 * ks + 8 * kq; }
        *(LAS v4u*)(lds + LW_OFF + i * 16) = *(const v4u*)src; }
    __syncthreads();
}
struct RwkvPre { bf16x8 bx[9]; };
template <int K0, int K1> __device__ __forceinline__ void rwkv_load(const Params& p, int b, int h, int ch, RwkvPre& pre, int lane) {
    const int t = lane & 15, q = lane >> 4;
    const bf16* LIN = (const bf16*)(p.ws + WS_LIN);
    const size_t row = (size_t)b * SEQ + ch * 16 + t;
#pragma unroll
    for (int ks = K0; ks < K1; ++ks) pre.bx[ks] = *(const bf16x8*)(LIN + row * LORA + 32 * ks + 8 * q);
}
__device__ __forceinline__ void rwkv_prep(const Params& p, int b, int h, int ch, LAS unsigned char* lds, LAS unsigned char* slot, LAS float* bonp, const RwkvPre& pre, int lane) {
    const int t = lane & 15, q = lane >> 4;
    int zo = 0; asm volatile("" : "+v"(zo));
    const LAS unsigned char* LW = lds + LW_OFF + zo + lane * 16; const LAS float* PRM = (const LAS float*)(lds + PRM_OFF + zo) + 16 * q;
    v4u cu[3][2], pu[3][2];
    { const bf16* prow = (const bf16*)(p.ws + WS_PR) + (((size_t)(b * RHEADS + h) * SEQ + ch * 16 + t) * 3) * 64 + 16 * q; const bool hasp = (ch * 16 + t) > 0; const bf16* pprev = hasp ? prow - 192 : prow;
#pragma unroll
      for (int a = 0; a < 3; ++a)
#pragma unroll
        for (int hf = 0; hf < 2; ++hf) { cu[a][hf] = *(const v4u*)(prow + a * 64 + 8 * hf); pu[a][hf] = *(const v4u*)(pprev + a * 64 + 8 * hf); }
      if (ch == 0) {
#pragma unroll
        for (int a = 0; a < 3; ++a)
#pragma unroll
          for (int hf = 0; hf < 2; ++hf) if (!hasp) pu[a][hf] = (v4u){0u, 0u, 0u, 0u}; } }
    const f32x4 z4 = (f32x4){0.f, 0.f, 0.f, 0.f};
    float lp[16];
    {
        f32x4 wacc[4] = {z4, z4, z4, z4};
#pragma unroll
        for (int ks = 0; ks < 2; ++ks)
            {
#pragma unroll
                for (int nt = 0; nt < 4; ++nt) wacc[nt] = __builtin_amdgcn_mfma_f32_16x16x32_bf16(*(const LAS bf16x8*)(LW + (nt * 2 + ks) * 1024), pre.bx[ks], wacc[nt], 0, 0, 0); __builtin_amdgcn_sched_barrier(0); }
#pragma unroll
        for (int nt = 0; nt < 4; ++nt) { const f32x4 w0 = *(const LAS f32x4*)(PRM + 0 * 64 + 4 * nt);
#pragma unroll
            for (int rr = 0; rr < 4; ++rr) lp[4 * nt + rr] = row_scanmul16(__builtin_amdgcn_exp2f(-0.8750387749f * sigmoidf_(w0[rr] + wacc[nt][rr]))); }
    }
    if (t == 15) {
#pragma unroll
        for (int nt = 0; nt < 4; ++nt) *(LAS f32x4*)(slot + SL_PL + (16 * q + 4 * nt) * 4) = (f32x4){lp[4 * nt], lp[4 * nt + 1], lp[4 * nt + 2], lp[4 * nt + 3]}; }
    float asg[16];
    {
        f32x4 aacc[4] = {z4, z4, z4, z4};
#pragma unroll
        for (int ks = 0; ks < 2; ++ks)
            {
#pragma unroll
                for (int nt = 0; nt < 4; ++nt) aacc[nt] = __builtin_amdgcn_mfma_f32_16x16x32_bf16(*(const LAS bf16x8*)(LW + (8 + nt * 2 + ks) * 1024), pre.bx[2 + ks], aacc[nt], 0, 0, 0); __builtin_amdgcn_sched_barrier(0); }
#pragma unroll
        for (int nt = 0; nt < 4; ++nt) { const f32x4 a0 = *(const LAS f32x4*)(PRM + 1 * 64 + 4 * nt);
#pragma unroll
            for (int rr = 0; rr < 4; ++rr) asg[4 * nt + rr] = sigmoidf_(a0[rr] + aacc[nt][rr]); }
    }
#define RW_SHIFT8(dst, a_) { const f32x4 m0 = *(const LAS f32x4*)(PRM + (7 + (a_)) * 64 + 8 * hf), m1 = *(const LAS f32x4*)(PRM + (7 + (a_)) * 64 + 8 * hf + 4); float a8[8], b8[8]; unpack8(cu[a_][hf], a8); unpack8(pu[a_][hf], b8); \
        _Pragma("unroll") for (int j = 0; j < 8; ++j) dst[j] = a8[j] + (b8[j] - a8[j]) * (j < 4 ? m0[j] : m1[j - 4]); }
#pragma unroll
    for (int hf = 0; hf < 2; ++hf) { float v8[8]; RW_SHIFT8(v8, 2) st16(slot + SL_VT + (t * CP + 16 * q + 8 * hf) * 2, pack8(v8)); }
    unsigned kkp[8]; float ss = 0.f, bon = 0.f;
    bf16x8 fa[2], fb[2], fk[2], fr[2];
#pragma unroll
    for (int hf = 0; hf < 2; ++hf) { float k8[8], r8[8], o[8]; RW_SHIFT8(k8, 1) RW_SHIFT8(r8, 0)
        const f32x4 kk0 = *(const LAS f32x4*)(PRM + 2 * 64 + 8 * hf), kk1 = *(const LAS f32x4*)(PRM + 2 * 64 + 8 * hf + 4), ka0 = *(const LAS f32x4*)(PRM + 3 * 64 + 8 * hf), ka1 = *(const LAS f32x4*)(PRM + 3 * 64 + 8 * hf + 4);
        const f32x4 rk0 = *(const LAS f32x4*)(PRM + 4 * 64 + 8 * hf), rk1 = *(const LAS f32x4*)(PRM + 4 * 64 + 8 * hf + 4);
        float kprev = 0.f;
#pragma unroll
        for (int j = 0; j < 8; ++j) { const int e = 8 * hf + j; const float kkc = j < 4 ? kk0[j] : kk1[j - 4], kac = j < 4 ? ka0[j] : ka1[j - 4], rkc = j < 4 ? rk0[j] : rk1[j - 4];
            const float kv = k8[j] * kkc; ss += kv * kv; if (j & 1) kkp[e >> 1] = pg8::cvt_pk_bf16(kprev, kv); kprev = kv;
            const float k2v = k8[j] * (1.0f + (asg[e] - 1.0f) * kac); bon += r8[j] * k2v * rkc;
            const float e1 = lp[e]; o[j] = k2v * __builtin_amdgcn_rcpf(e1); r8[j] = r8[j] * e1; }
        v4u w = pack8(o); fk[hf] = __builtin_bit_cast(bf16x8, w); st16(slot + SL_KT + (t * CP + 16 * q + 8 * hf) * 2, w);
        w = pack8(r8); fr[hf] = __builtin_bit_cast(bf16x8, w); st16(slot + SL_RT + (t * CP + 16 * q + 8 * hf) * 2, w); }
#undef RW_SHIFT8
    ss += __shfl_xor(ss, 16); ss += __shfl_xor(ss, 32); bon += __shfl_xor(bon, 16); bon += __shfl_xor(bon, 32);
    if (q == 0) bonp[t] = bon;
    const float inv = 1.0f / fmaxf(sqrtf(ss), 1e-12f);
#pragma unroll
    for (int hf = 0; hf < 2; ++hf) { float oa[8], ob[8];
#pragma unroll
        for (int j = 0; j < 8; ++j) { const int e = 8 * hf + j; const float kn = ((e & 1) ? bfhi(kkp[e >> 1]) : bflo(kkp[e >> 1])) * inv; oa[j] = -kn * dpp_mov1<0x111>(lp[e]); ob[j] = kn * asg[e] * __builtin_amdgcn_rcpf(lp[e]); }
        v4u w = pack8(oa); fa[hf] = __builtin_bit_cast(bf16x8, w); st16(slot + SL_AT + (t * CP + 16 * q + 8 * hf) * 2, w);
        w = pack8(ob); fb[hf] = __builtin_bit_cast(bf16x8, w); st16(slot + SL_BT + (t * CP + 16 * q + 8 * hf) * 2, w); }
    f32x4 G = z4, GT_ = z4, GakT = z4, GrkT = z4, GrbT = z4;
#pragma unroll
    for (int hf = 0; hf < 2; ++hf) {
        G = __builtin_amdgcn_mfma_f32_16x16x32_bf16(fa[hf], fb[hf], G, 0, 0, 0);
        GT_ = __builtin_amdgcn_mfma_f32_16x16x32_bf16(fb[hf], fa[hf], GT_, 0, 0, 0);
        GakT = __builtin_amdgcn_mfma_f32_16x16x32_bf16(fk[hf], fa[hf], GakT, 0, 0, 0);
        GrkT = __builtin_amdgcn_mfma_f32_16x16x32_bf16(fk[hf], fr[hf], GrkT, 0, 0, 0);
        GrbT = __builtin_amdgcn_mfma_f32_16x16x32_bf16(fb[hf], fr[hf], GrbT, 0, 0, 0);
    }
    f32x4 I4;
#pragma unroll
    for (int rr = 0; rr < 4; ++rr) { const int rw = 4 * q + rr;
        I4[rr] = (rw == t) ? 1.0f : 0.0f;
        G[rr] = (rw > t) ? G[rr] : 0.f;
        GT_[rr] = (t > rw) ? GT_[rr] : 0.f;
        GakT[rr] = (t > rw) ? GakT[rr] : 0.f;
        GrkT[rr] = (t >= rw) ? GrkT[rr] : 0.f;
        GrbT[rr] = (t >= rw) ? GrbT[rr] : 0.f; }
    const f32x4 G2 = mm16(GT_, G), G2T = mm16(G, GT_);
    const f32x4 G4 = mm16(G2T, G2), G4T = mm16(G2, G2T);
    const f32x4 G8 = mm16(G4T, G4), G8T = mm16(G4, G4T);
    const f32x4 P1 = mm16(I4 + GT_, I4 + G2), P1T = mm16(I4 + G2, I4 + GT_);
    const f32x4 P2 = mm16(P1T, I4 + G4), P2T = mm16(I4 + G4, P1T);
    const f32x4 Tt = mm16(P2T, I4 + G8), TtT = mm16(I4 + G8, P2T);
    (void)G8T; (void)P2;
    const f32x4 GTmT = mm16(Tt, GrbT);
    *(LAS s16x4*)(slot + SL_GAK + t * 32 + q * 8) = pack4(GakT);
    *(LAS s16x4*)(slot + SL_GRK + t * 32 + q * 8) = pack4(GrkT);
    *(LAS s16x4*)(slot + SL_TT + t * 32 + q * 8) = pack4(TtT);
    *(LAS s16x4*)(slot + SL_GT + t * 32 + q * 8) = pack4(GTmT);
}
__device__ __forceinline__ void rwkv_post(const Params& p, int b, int h, int ch, const LAS unsigned char* lds, float bon, const LAS unsigned char* yb, const v4u (&vk)[2], const RwkvPre& pre, int lane) {
    const int t = lane & 15, q = lane >> 4, hc = h * 64 + 16 * q;
    bf16* YA = (bf16*)(p.ws + WS_YA);
    int zo = 0; asm volatile("" : "+v"(zo));
    const LAS unsigned char* LW = lds + LW_OFF + zo + lane * 16;
    const LAS float* pLW = (const LAS float*)(lds + PRM_OFF + zo) + 5 * 64 + 16 * q; const LAS float* pLB = pLW + 64;
    const f32x4 z4 = (f32x4){0.f, 0.f, 0.f, 0.f};
    f32x4 gacc[4] = {z4, z4, z4, z4};
#pragma unroll
    for (int ks = 0; ks < 5; ++ks)
        {
#pragma unroll
            for (int nt = 0; nt < 4; ++nt) gacc[nt] = __builtin_amdgcn_mfma_f32_16x16x32_bf16(*(const LAS bf16x8*)(LW + (16 + nt * 5 + ks) * 1024), pre.bx[4 + ks], gacc[nt], 0, 0, 0); __builtin_amdgcn_sched_barrier(0); }
    float y[16], v[16];
#pragma unroll
    for (int hf = 0; hf < 2; ++hf) { float o[8]; unpack8(*(const LAS v4u*)(yb + (t * 64 + 16 * q + 8 * hf) * 2), o);
#pragma unroll
        for (int j = 0; j < 8; ++j) y[8 * hf + j] = o[j];
        unpack8(vk[hf], o);
#pragma unroll
        for (int j = 0; j < 8; ++j) v[8 * hf + j] = o[j]; }
    float s = 0.f;
#pragma unroll
    for (int e = 0; e < 16; ++e) s += y[e];
    s += __shfl_xor(s, 16); s += __shfl_xor(s, 32);
    const float mean = s * (1.f / 64.f); float s2 = 0.f;
#pragma unroll
    for (int e = 0; e < 16; ++e) { y[e] -= mean; s2 += y[e] * y[e]; }
    s2 += __shfl_xor(s2, 16); s2 += __shfl_xor(s2, 32);
    const float rstd = 1.0f / sqrtf(s2 * (1.f / 64.f) + GN_EPS);
    const size_t row = (size_t)b * SEQ + ch * 16 + t;
#pragma unroll
    for (int hf = 0; hf < 2; ++hf) { float o[8];
#pragma unroll
        for (int j = 0; j < 8; ++j) { const int e = 8 * hf + j; o[j] = (y[e] * rstd * pLW[e] + pLB[e] + bon * v[e]) * gacc[2 * hf + (j >> 2)][j & 3]; }
        *(v4u*)(YA + row * RW + hc + 8 * hf) = pack8(o); }
}
__device__ __forceinline__ void rwkv_step(const LAS unsigned char* slot, LAS unsigned char* yb, f32x4 (&X)[4], int i0, int lane) {
    const int li = lane & 15, q = lane >> 4;
    const f32x4 z4 = (f32x4){0.f, 0.f, 0.f, 0.f};
    const bf16x8 xb0 = cat8(pack4(X[0]), pack4(X[1])), xb1 = cat8(pack4(X[2]), pack4(X[3]));
    const LAS unsigned char* arow = slot + SL_AT + li * CP * 2 + q * 8; const LAS unsigned char* rrow = slot + SL_RT + li * CP * 2 + q * 8;
    const bf16x8 a0 = cat8(*(const LAS s16x4*)(arow), *(const LAS s16x4*)(arow + 32)), a1 = cat8(*(const LAS s16x4*)(arow + 64), *(const LAS s16x4*)(arow + 96));
    const bf16x8 r0 = cat8(*(const LAS s16x4*)(rrow), *(const LAS s16x4*)(rrow + 32)), r1 = cat8(*(const LAS s16x4*)(rrow + 64), *(const LAS s16x4*)(rrow + 96));
    const unsigned troff = (unsigned)((4 * q + (li >> 2)) * CP * 2 + (li & 3) * 8);
    const s16x4 vb = __builtin_amdgcn_ds_read_tr16_b64_v4i16((LAS s16x4*)(slot + SL_VT + troff + i0 * 2));
    const s16x4 gak = *(const LAS s16x4*)(slot + SL_GAK + li * 32 + q * 8), grk = *(const LAS s16x4*)(slot + SL_GRK + li * 32 + q * 8);
    const s16x4 tt = *(const LAS s16x4*)(slot + SL_TT + li * 32 + q * 8), gt = *(const LAS s16x4*)(slot + SL_GT + li * 32 + q * 8);
    s16x4 bT[4], kT[4]; f32x4 pl[4];
#pragma unroll
    for (int jt = 0; jt < 4; ++jt) { bT[jt] = __builtin_amdgcn_ds_read_tr16_b64_v4i16((LAS s16x4*)(slot + SL_BT + troff + jt * 32)); kT[jt] = __builtin_amdgcn_ds_read_tr16_b64_v4i16((LAS s16x4*)(slot + SL_KT + troff + jt * 32));
        pl[jt] = *(const LAS f32x4*)(slot + SL_PL + (16 * jt + 4 * q) * 4); }
    LDS_WAIT();
    f32x4 PA = __builtin_amdgcn_mfma_f32_16x16x32_bf16(a0, xb0, z4, 0, 0, 0); PA = __builtin_amdgcn_mfma_f32_16x16x32_bf16(a1, xb1, PA, 0, 0, 0);
    f32x4 PRr = __builtin_amdgcn_mfma_f32_16x16x32_bf16(r0, xb0, z4, 0, 0, 0); PRr = __builtin_amdgcn_mfma_f32_16x16x32_bf16(r1, xb1, PRr, 0, 0, 0);
    PA = __builtin_amdgcn_mfma_f32_16x16x16bf16_1k(gak, vb, PA, 0, 0, 0);
    PRr = __builtin_amdgcn_mfma_f32_16x16x16bf16_1k(grk, vb, PRr, 0, 0, 0);
    const s16x4 pa4 = pack4(PA);
    const f32x4 SA = __builtin_amdgcn_mfma_f32_16x16x16bf16_1k(tt, pa4, z4, 0, 0, 0);
    const f32x4 Y = __builtin_amdgcn_mfma_f32_16x16x16bf16_1k(gt, pa4, PRr, 0, 0, 0);
    const bf16x8 sb = cat8(pack4(SA), vb);
#pragma unroll
    for (int jt = 0; jt < 4; ++jt) {
        X[jt] = __builtin_amdgcn_mfma_f32_16x16x32_bf16(cat8(bT[jt], kT[jt]), sb, X[jt], 0, 0, 0);
        X[jt] = X[jt] * pl[jt]; }
    { const unsigned y01 = pg8::cvt_pk_bf16(Y[0], Y[1]), y23 = pg8::cvt_pk_bf16(Y[2], Y[3]);
      *(LAS bf16*)(yb + ((4 * q + 0) * 64 + i0 + li) * 2) = (bf16)(y01 & 0xffffu); *(LAS bf16*)(yb + ((4 * q + 1) * 64 + i0 + li) * 2) = (bf16)(y01 >> 16);
      *(LAS bf16*)(yb + ((4 * q + 2) * 64 + i0 + li) * 2) = (bf16)(y23 & 0xffffu); *(LAS bf16*)(yb + ((4 * q + 3) * 64 + i0 + li) * 2) = (bf16)(y23 >> 16); }
}
__device__ __forceinline__ void rwkv_slot(const Params& p, int b, int h, int s, int NS, LAS unsigned char* lds, v4u (&vk)[2], float& bk, RwkvPre& pre, f32x4 (&X)[4], int wave, int lane) {
    const int j = wave & 3;
    if (wave >= 4) {
        if (s < NS) { rwkv_prep(p, b, h, 4 * s + j, lds, lds + ((s & 1) * 4 + j) * SLOT_BYTES, (LAS float*)(lds + BON_OFF) + ((s & 1) * 4 + j) * 16, pre, lane);
            if (s + 1 < NS) rwkv_load<0, 4>(p, b, h, 4 * (s + 1) + j, pre, lane); }
    } else {
        if (s >= 1 && s <= NS) {
            const int bank = ((s - 1) & 1) * 4;
#pragma unroll 1
            for (int cc = 0; cc < 4; ++cc) rwkv_step(lds + (bank + cc) * SLOT_BYTES, lds + YB_OFF + (bank + cc) * YB_CHUNK, X, 16 * wave, lane);
        }
        if (s >= 2) { rwkv_post(p, b, h, 4 * (s - 2) + j, lds, bk, lds + YB_OFF + ((s & 1) * 4 + j) * YB_CHUNK, vk, pre, lane);
            if (s - 1 < NS) rwkv_load<4, 9>(p, b, h, 4 * (s - 1) + j, pre, lane); }
        if (s >= 1 && s <= NS) { const int t = lane & 15, q = lane >> 4; const LAS unsigned char* va = lds + (((s - 1) & 1) * 4 + j) * SLOT_BYTES + SL_VT + (t * CP + 16 * q) * 2;
#pragma unroll
            for (int hf = 0; hf < 2; ++hf) { const v2u v0 = *(const LAS v2u*)(va + 16 * hf), v1 = *(const LAS v2u*)(va + 16 * hf + 8); vk[hf] = (v4u){v0.x, v0.y, v1.x, v1.y}; }
            bk = ((const LAS float*)(lds + BON_OFF))[(((s - 1) & 1) * 4 + j) * 16 + t]; }
    }
    LDS_WAIT(); __builtin_amdgcn_s_barrier(); asm volatile("" ::: "memory");
}
__device__ __forceinline__ void rwkv_unit_c(const Params& p, int unit, LAS unsigned char* lds, int wave, int lane) {
    const int b = unit >> 4, h = unit & 15;
    f32x4 X[4];
#pragma unroll
    for (int jt = 0; jt < 4; ++jt) X[jt] = (f32x4){0.f, 0.f, 0.f, 0.f};
    v4u vk[2]; vk[0] = vk[1] = (v4u){0u, 0u, 0u, 0u}; float bk = 0.f;
    rwkv_stage(p, h, lds, threadIdx.x);
    constexpr int NS = SEQ / 64;
    RwkvPre pre; rwkv_load<0, 9>(p, b, h, wave & 3, pre, lane);
    for (int s = 0; s <= NS + 1; ++s) rwkv_slot(p, b, h, s, NS, lds, vk, bk, pre, X, wave, lane);
    __syncthreads();
}
__device__ __forceinline__ void sincos_acc(float x, float& s, float& c) {
    const float n = rintf(x * 0.636619772367581343f);
    float r = fmaf(n, -1.5707962513e+00f, x); r = fmaf(n, -7.5497894159e-08f, r); r = fmaf(n, -5.3903029534e-15f, r);
    const float r2 = r * r;
    float sp = fmaf(r2, 2.86567956e-6f, -1.98559923e-4f); sp = fmaf(sp, r2, 8.33338592e-3f); sp = fmaf(sp, r2, -1.66666672e-1f); sp = fmaf(sp * r2, r, r);
    float cp = fmaf(r2, 2.44677067e-5f, -1.38877297e-3f); cp = fmaf(cp, r2, 4.16666567e-2f); cp = fmaf(cp, r2, -0.5f); cp = fmaf(cp, r2, 1.0f);
    const int q = ((int)n) & 3;
    const float ss = (q & 1) ? cp : sp, cc = (q & 1) ? sp : cp;
    s = (q & 2) ? -ss : ss; c = ((q + 1) & 2) ? -cc : cc;
}
__device__ __forceinline__ float gelu_tanh(float y) { const float a = 0.7978845608028654f * (y + 0.044715f * y * y * y); const float t = 1.0f - 2.0f * __builtin_amdgcn_rcpf(1.0f + __expf(2.0f * a)); return 0.5f * y * (1.0f + t); }
constexpr int S5_BU_PITCH = 132, S5_XS_PITCH = 136, S5_WAVE_LDS = 32 * S5_BU_PITCH * 4 + 32 * S5_XS_PITCH * 2;
__device__ __forceinline__ void s5_unit(const Params& p, int unit, LAS unsigned char* wl, int lane) {
    const int b = unit >> 6, g = unit & 63;
    LAS float* BU = (LAS float*)wl; LAS bf16* XS = (LAS bf16*)(wl + 32 * S5_BU_PITCH * 4);
    const bf16* U = (const bf16*)(p.ws + WS_U) + (size_t)(b * S5NG + g) * SEQ * 16;
    unsigned char* Z = p.ws + WS_Z;
    const float st = __expf(p.in[I_LSTEP][g]);
    const float* lre = p.in[I_LRE] + g * 64; const float* lim = p.in[I_LIM] + g * 64;
    float ar, ai; { const float lr = lre[lane], li = lim[lane]; const float ea = __expf(lr * st); float sn, cs; sincos_acc(li * st, sn, cs); ar = ea * cs; ai = ea * sn; }
    const int half = lane >> 5, l31 = lane & 31;
    bf16x8 bfrag[4];
#pragma unroll
    for (int nt = 0; nt < 4; ++nt) { const int pp = 16 * nt + (l31 >> 1); const bool im = (l31 & 1) != 0;
        const float lr = lre[pp], li = lim[pp]; const float ea = __expf(lr * st); float sn, cs; sincos_acc(li * st, sn, cs);
        const float nr = ea * cs - 1.0f, ni = ea * sn, d2 = lr * lr + li * li; const float qr = (nr * lr + ni * li) / d2, qi = (ni * lr - nr * li) / d2;
        const float* brp = p.in[I_BRE] + ((size_t)(g * 64 + pp) * 16 + 8 * half); const float* bip = p.in[I_BIM] + ((size_t)(g * 64 + pp) * 16 + 8 * half);
        const f32x4 br0 = *(const f32x4*)brp, br1 = *(const f32x4*)(brp + 4), bi0 = *(const f32x4*)bip, bi1 = *(const f32x4*)(bip + 4);
        float o[8];
#pragma unroll
        for (int j = 0; j < 8; ++j) { const float br = j < 4 ? br0[j] : br1[j - 4], bi = j < 4 ? bi0[j] : bi1[j - 4]; o[j] = im ? (qr * bi + qi * br) : (qr * br - qi * bi); }
        bfrag[nt] = __builtin_bit_cast(bf16x8, pack8(o)); }
    const int hh = lane & 15, q4 = lane >> 4;
    bf16x8 cfrag[4];
#pragma unroll
    for (int ks = 0; ks < 4; ++ks) { const int pb = 16 * ks + 4 * q4;
        const f32x4 cr = *(const f32x4*)(p.in[I_CRE] + ((size_t)(g * 16 + hh) * 64 + pb)), ci = *(const f32x4*)(p.in[I_CIM] + ((size_t)(g * 16 + hh) * 64 + pb));
        float o[8];
#pragma unroll
        for (int j = 0; j < 4; ++j) { o[2 * j] = cr[j]; o[2 * j + 1] = -ci[j]; }
        cfrag[ks] = __builtin_bit_cast(bf16x8, pack8(o)); }
    const f32x4 dsk = *(const f32x4*)(p.in[I_SD] + g * 16 + 4 * q4);
    float xr = 0.f, xi = 0.f;
    const bf16* ua = U + (size_t)l31 * 16 + 8 * half;
    const bf16* ud = U + (size_t)hh * 16 + 4 * q4;
    bf16x8 au_n = *(const bf16x8*)ua; v2u uq_n0 = *(const v2u*)ud, uq_n1 = *(const v2u*)(ud + 16 * 16);
    for (int sc = 0; sc < SEQ / 32; ++sc) {
        const size_t row0 = (size_t)b * SEQ + sc * 32;
        const bf16x8 au = au_n; const v2u uqs[2] = {uq_n0, uq_n1};
        if (sc + 1 < SEQ / 32) { au_n = *(const bf16x8*)(ua + (size_t)(sc + 1) * 512); uq_n0 = *(const v2u*)(ud + (size_t)(sc + 1) * 512); uq_n1 = *(const v2u*)(ud + (size_t)(sc + 1) * 512 + 256); }
        f32x16 acc[4];
#pragma unroll
        for (int nt = 0; nt < 4; ++nt) {
#pragma unroll
            for (int i = 0; i < 16; ++i) acc[nt][i] = 0.f;
            acc[nt] = __builtin_amdgcn_mfma_f32_32x32x16_bf16(au, bfrag[nt], acc[nt], 0, 0, 0); }
#pragma unroll
        for (int nt = 0; nt < 4; ++nt)
#pragma unroll
            for (int i = 0; i < 16; ++i) { const int t = (i & 3) + 8 * (i >> 2) + 4 * half; BU[t * S5_BU_PITCH + 32 * nt + l31] = acc[nt][i]; }
        LDS_WAIT();
#pragma unroll
        for (int hb = 0; hb < 2; ++hb) {
            pg8::f32x2_ bb[16];
#pragma unroll
            for (int t = 0; t < 16; ++t) bb[t] = *(const LAS pg8::f32x2_*)(BU + (16 * hb + t) * S5_BU_PITCH + 2 * lane);
#pragma unroll
            for (int t = 0; t < 16; ++t) { const float nr = ar * xr - ai * xi + bb[t].x, ni = ar * xi + ai * xr + bb[t].y; xr = nr; xi = ni;
                *(LAS unsigned*)(XS + (16 * hb + t) * S5_XS_PITCH + 2 * lane) = pg8::cvt_pk_bf16(xr, xi); } }
        LDS_WAIT();
#pragma unroll
        for (int nt = 0; nt < 2; ++nt) {
            f32x4 ay = (f32x4){0.f, 0.f, 0.f, 0.f};
#pragma unroll
            for (int ks = 0; ks < 4; ++ks) { const bf16x8 xb = *(const LAS bf16x8*)(XS + (16 * nt + hh) * S5_XS_PITCH + 32 * ks + 8 * q4);
                ay = __builtin_amdgcn_mfma_f32_16x16x32_bf16(cfrag[ks], xb, ay, 0, 0, 0); }
            const size_t row = row0 + 16 * nt + hh;
            const v2u uq = uqs[nt];
            const float y0 = ay[0] + dsk[0] * bflo(uq.x), y1 = ay[1] + dsk[1] * bfhi(uq.x), y2 = ay[2] + dsk[2] * bflo(uq.y), y3 = ay[3] + dsk[3] * bfhi(uq.y);
            constexpr float zs = (float)(1 << GLU_Z_SH);
            *(unsigned*)(Z + row * S5W + g * 16 + 4 * q4) = pk4_fp8(gelu_tanh(y0) * zs, gelu_tanh(y1) * zs, gelu_tanh(y2) * zs, gelu_tanh(y3) * zs); }
        LDS_WAIT();
    }
}

__device__ __forceinline__ void moe_tables(const unsigned* cnt, LAS int* tb, LAS int* cntl, int tid) {
    if (tid < NEXP) cntl[tid] = (int)__hip_atomic_load(cnt + tid, __ATOMIC_RELAXED, __HIP_MEMORY_SCOPE_AGENT);
    __syncthreads();
    if (tid == 0) { int s = 0; for (int e = 0; e < NEXP; ++e) { tb[e] = s; s += (cntl[e] + 255) >> 8; } tb[NEXP] = s; }
    __syncthreads();
}
__device__ __forceinline__ void p7_pass2(const bf16* __restrict__ xr, const bf16* __restrict__ rt, const float* __restrict__ gain, unsigned char* __restrict__ h8, float rs, f32x4 (&acc)[3]) {
#pragma unroll 8
    for (int ks = 0; ks < 64; ++ks) { float x8[8]; unpack8(*(const v4u*)(xr + 32 * ks), x8);
        const f32x4 g0 = *(const f32x4*)(gain + 32 * ks), g1 = *(const f32x4*)(gain + 32 * ks + 4);
#pragma unroll
        for (int j = 0; j < 8; ++j) x8[j] = x8[j] * rs * (j < 4 ? g0[j] : g1[j - 4]);
        const bf16x8 a = __builtin_bit_cast(bf16x8, pack8(x8));
        *(v2u*)(h8 + 32 * ks) = (v2u){pk4_fp8(x8[0], x8[1], x8[2], x8[3]), pk4_fp8(x8[4], x8[5], x8[6], x8[7])};
#pragma unroll
        for (int nt = 0; nt < 3; ++nt) { const bf16x8 b = *(const bf16x8*)(rt + (size_t)(16 * nt) * D + 32 * ks); acc[nt] = __builtin_amdgcn_mfma_f32_16x16x32_bf16(a, b, acc[nt], 0, 0, 0); } }
}
__device__ __forceinline__ void p7_norm_route(const Params& p, LAS unsigned char* lds, int tid, int wave, int lane) {
    LAS int* hist = (LAS int*)lds; LAS int* hb = hist + 32;
    LAS float* LGW = (LAS float*)(lds + 1024 + wave * 3328);
    const bf16* X1 = (const bf16*)(p.ws + WS_X1); const bf16* RT = (const bf16*)(p.ws + WS_RT); unsigned char* H8 = p.ws + WS_H28; const float* gain = p.in[I_NFG];
    unsigned* cnt = (unsigned*)(p.ws + WS_CTL) + CW_CNT; int* toki = (int*)(p.ws + WS_TOKI); float* tokw = (float*)(p.ws + WS_TOKW); int* list = (int*)(p.ws + WS_LIST);
    const int m = lane & 15, kq = lane >> 4;
    for (int base = blockIdx.x * 128; base < M; base += gridDim.x * 128) {
        if (tid < 32) hist[tid] = 0;
        __syncthreads();
        const int row = base + wave * 16 + m;
        const bf16* xr = X1 + (size_t)row * D + 8 * kq;
        float s = 0.f;
#pragma unroll 16
        for (int ks = 0; ks < 64; ++ks) { float x8[8]; unpack8(*(const v4u*)(xr + 32 * ks), x8);
#pragma unroll
            for (int j = 0; j < 8; ++j) s += x8[j] * x8[j]; }
        s += __shfl_xor(s, 16); s += __shfl_xor(s, 32);
        const float rs = 1.0f / sqrtf(s * (1.f / D) + RMS_EPS);
        f32x4 acc[3] = {(f32x4){0.f, 0.f, 0.f, 0.f}, (f32x4){0.f, 0.f, 0.f, 0.f}, (f32x4){0.f, 0.f, 0.f, 0.f}};
        p7_pass2(xr, RT + (size_t)m * D + 8 * kq, gain + 8 * kq, H8 + (size_t)row * D + 8 * kq, rs, acc);
#pragma unroll
        for (int nt = 0; nt < 3; ++nt)
#pragma unroll
            for (int rr = 0; rr < 4; ++rr) LGW[(4 * kq + rr) * 52 + 16 * nt + m] = acc[nt][rr];
        LDS_WAIT();
        int e0 = 0, e1 = 0, r0 = 0, r1 = 0; float w0 = 0.f, w1 = 0.f; const int tok = base + wave * 16 + lane;
        if (lane < 16) {
            const LAS float* lg = LGW + lane * 52;
            float gl[4]; int gi = 0; float gm;
#pragma unroll
            for (int j = 0; j < 4; ++j) gl[j] = lg[j] + p.in[I_RGB][j];
            gm = gl[0];
#pragma unroll
            for (int j = 1; j < 4; ++j) if (gl[j] > gm) { gm = gl[j]; gi = j; }
            float den = 0.f;
#pragma unroll
            for (int j = 0; j < 4; ++j) den += __expf(gl[j] - gm);
            const float gp = 1.0f / den;
            float l0 = -3.0e38f, l1 = -3.0e38f; int i0 = 0, i1 = 0;
#pragma unroll
            for (int j = 0; j < 8; ++j) { const float v = lg[4 + gi * 8 + j] + p.in[I_REB][gi * 8 + j];
                if (v > l0) { l1 = l0; i1 = i0; l0 = v; i0 = j; } else if (v > l1) { l1 = v; i1 = j; } }
            const float ex = __expf(l1 - l0); w0 = gp / (1.0f + ex); w1 = gp * ex / (1.0f + ex);
            e0 = gi * 8 + i0; e1 = gi * 8 + i1;
            r0 = __hip_atomic_fetch_add(&hist[e0], 1, __ATOMIC_RELAXED, __HIP_MEMORY_SCOPE_WORKGROUP); r1 = __hip_atomic_fetch_add(&hist[e1], 1, __ATOMIC_RELAXED, __HIP_MEMORY_SCOPE_WORKGROUP);
        }
        __syncthreads();
        if (tid < 32) { const int c = hist[tid]; hb[tid] = c ? (int)__hip_atomic_fetch_add(cnt + tid, (unsigned)c, __ATOMIC_RELAXED, __HIP_MEMORY_SCOPE_AGENT) : 0; }
        __syncthreads();
        if (lane < 16) { const int p0 = hb[e0] + r0, p1 = hb[e1] + r1;
            list[(size_t)e0 * CAP + p0] = tok; list[(size_t)e1 * CAP + p1] = tok;
            *(int4*)(toki + (size_t)tok * 4) = make_int4(e0, e1, p0, p1); *(float2*)(tokw + (size_t)tok * 2) = make_float2(w0, w1); }
        __syncthreads();
    }
}
__device__ __forceinline__ void p11_final(const Params& p, const LAS int* tb, int gw, int NGW, int lane) {
    const unsigned char* Y2 = p.ws + WS_Y2; const bf16* X1 = (const bf16*)(p.ws + WS_X1); const int* toki = (const int*)(p.ws + WS_TOKI); const float* tokw = (const float*)(p.ws + WS_TOKW);
    f32x4 g[8];
#pragma unroll
    for (int j = 0; j < 8; ++j) g[j] = ((const f32x4*)p.in[I_NFIN] + lane)[64 * j];
    if (gw >= M) return;
    const float ysc = 1.0f / (float)(1 << Y2_SH);
    int4 ti = *(const int4*)(toki + (size_t)gw * 4); float2 tw = *(const float2*)(tokw + (size_t)gw * 2);
    v2u xw[8], xwn[8]; unsigned ya[8], yc[8], yan[8], ycn[8];
    { const size_t q0 = (size_t)tb[ti.x] * 256 + ti.z, q1 = (size_t)tb[ti.y] * 256 + ti.w;
#pragma unroll
      for (int j = 0; j < 8; ++j) { xw[j] = ((const v2u*)(X1 + (size_t)gw * D) + lane)[64 * j]; ya[j] = ((const unsigned*)(Y2 + q0 * D) + lane)[64 * j]; yc[j] = ((const unsigned*)(Y2 + q1 * D) + lane)[64 * j]; } }
    int m1 = gw + NGW < M ? gw + NGW : gw;
    int4 tin = *(const int4*)(toki + (size_t)m1 * 4); float2 twn = *(const float2*)(tokw + (size_t)m1 * 2);
    for (int m = gw; m < M; m += NGW) {
        const int mn = m + NGW < M ? m + NGW : m, mnn = mn + NGW < M ? mn + NGW : mn;
        { const size_t q0 = (size_t)tb[tin.x] * 256 + tin.z, q1 = (size_t)tb[tin.y] * 256 + tin.w;
#pragma unroll
          for (int j = 0; j < 8; ++j) { xwn[j] = ((const v2u*)(X1 + (size_t)mn * D) + lane)[64 * j]; yan[j] = ((const unsigned*)(Y2 + q0 * D) + lane)[64 * j]; ycn[j] = ((const unsigned*)(Y2 + q1 * D) + lane)[64 * j]; } }
        const int4 tinn = *(const int4*)(toki + (size_t)mnn * 4); const float2 twnn = *(const float2*)(tokw + (size_t)mnn * 2);
        const float w0 = tw.x * ysc, w1 = tw.y * ysc;
        f32x4 v[8]; float s = 0.f;
#pragma unroll
        for (int j = 0; j < 8; ++j) {
            const pg8::f32x2_ a0 = __builtin_amdgcn_cvt_pk_f32_fp8((int)ya[j], false), a1 = __builtin_amdgcn_cvt_pk_f32_fp8((int)ya[j], true), c0 = __builtin_amdgcn_cvt_pk_f32_fp8((int)yc[j], false), c1 = __builtin_amdgcn_cvt_pk_f32_fp8((int)yc[j], true);
            f32x4 x; x.x = bflo(xw[j].x) + w0 * a0[0] + w1 * c0[0]; x.y = bfhi(xw[j].x) + w0 * a0[1] + w1 * c0[1]; x.z = bflo(xw[j].y) + w0 * a1[0] + w1 * c1[0]; x.w = bfhi(xw[j].y) + w0 * a1[1] + w1 * c1[1];
            v[j] = x; s += (x.x * x.x + x.y * x.y) + (x.z * x.z + x.w * x.w); }
        const float rs = 1.0f / sqrtf(wave_sum(s) * (1.f / D) + RMS_EPS);
        f32x4* orow = (f32x4*)(p.out + (size_t)m * D) + lane;
#pragma unroll
        for (int j = 0; j < 8; ++j) orow[64 * j] = v[j] * rs * g[j];
#pragma unroll
        for (int j = 0; j < 8; ++j) { xw[j] = xwn[j]; ya[j] = yan[j]; yc[j] = ycn[j]; }
        tw = twn; tin = tinn; twn = twnn; (void)ti;
    }
}

__device__ __forceinline__ void phase_0(const Params& p, LAS unsigned char* lds, unsigned char* ws, unsigned* ctl, LAS int* tb, LAS int* cntl, int G, int tid, int wave, int lane, int gw, int NGW) { p0_prologue(p, lds, gw, NGW, wave, lane); }
__device__ __forceinline__ void phase_1(const Params& p, LAS unsigned char* lds, unsigned char* ws, unsigned* ctl, LAS int* tb, LAS int* cntl, int G, int tid, int wave, int lane, int gw, int NGW) {
    {
        pg8::Gemm g{ws + WS_H, ws + WS_WIN, D}; pg8::StaticOrder S; S.init(M, 3 * RW, G, (int)blockIdx.x);
        EpiProj E{(bf16*)(ws + WS_PR), (bf16*)(ws + WS_U), 0};
        pg8::gemm_phase<EpiProj, pg8::StaticOrder, true>(lds, g, S, E); }
    {
        pg8::Gemm g{ws + WS_H28, ws + WS_WINU8, D, 127 * 0x01010101, (127 - MOE_WGU_SH) * 0x01010101}; pg8::StaticOrder S; S.init(M, 512 + S5W, G, (int)blockIdx.x);
        EpiProj E{(bf16*)(ws + WS_PR), (bf16*)(ws + WS_U), 12};
        pg8::gemm_phase<EpiProj, pg8::StaticOrder, true, true>(lds, g, S, E); }
}
__device__ __forceinline__ void lin_pass(const Params& p, unsigned char* ws, int tix, int nthreads) {
    const bf16* LOR = (const bf16*)(ws + WS_PR) + (size_t)M * (3 * RW); bf16* LIN = (bf16*)(ws + WS_LIN); const float* mu = p.in[I_MU] + 3 * RW;
    constexpr int NIT = M * (LORA / 8);
    for (int it0 = tix; it0 < NIT; it0 += 4 * nthreads) {
        v4u cq[4], pq[4]; int rows[4], cols[4];
#pragma unroll
        for (int k = 0; k < 4; ++k) { const int it = it0 + k * nthreads; const int itc = it < NIT ? it : it0; rows[k] = itc / (LORA / 8); cols[k] = 8 * (itc - rows[k] * (LORA / 8));
            cq[k] = *(const v4u*)(LOR + (size_t)rows[k] * 512 + cols[k]); pq[k] = (v4u){0u, 0u, 0u, 0u}; if ((rows[k] & (SEQ - 1)) != 0) pq[k] = *(const v4u*)(LOR + (size_t)(rows[k] - 1) * 512 + cols[k]); }
#pragma unroll
        for (int k = 0; k < 4; ++k) { const int col = cols[k];
            const f32x4 m0 = *(const f32x4*)(mu + col), m1 = *(const f32x4*)(mu + col + 4);
            float c8[8], p8[8]; unpack8(cq[k], c8); unpack8(pq[k], p8);
#pragma unroll
            for (int j = 0; j < 8; ++j) { float x = c8[j] + (p8[j] - c8[j]) * (j < 4 ? m0[j] : m1[j - 4]); if (col < DEC_R) x = tanh_fast(x); else if (col >= DEC_R + AAA_R) x = sigmoidf_(x); c8[j] = x; }
            if (it0 + k * nthreads < NIT) *(v4u*)(LIN + (size_t)rows[k] * LORA + col) = pack8(c8); } }
}
__device__ __forceinline__ void phase_2(const Params& p, LAS unsigned char* lds, unsigned char* ws, unsigned* ctl, LAS int* tb, LAS int* cntl, int G, int tid, int wave, int lane, int gw, int NGW) {
    if (wave < 4) { for (int u = blockIdx.x * 4 + wave; u < BATCH * S5NG; u += G * 4) s5_unit(p, u, lds + wave * S5_WAVE_LDS, lane); }
    else { lin_pass(p, ws, (blockIdx.x * 4 + (wave - 4)) * 64 + lane, G * 256);
           p2_convert(p, (LAS float*)(lds + 4 * S5_WAVE_LDS + (wave - 4) * 8448), blockIdx.x * 4 + (wave - 4), G * 4, lane); }
    __syncthreads();
}
__device__ __forceinline__ void phase_3(const Params& p, LAS unsigned char* lds, unsigned char* ws, unsigned* ctl, LAS int* tb, LAS int* cntl, int G, int tid, int wave, int lane, int gw, int NGW) {
    for (int u = blockIdx.x; u < BATCH * RHEADS; u += G) rwkv_unit_c(p, u, lds, wave, lane);
    __syncthreads();
}
__device__ __forceinline__ void phase_4(const Params& p, LAS unsigned char* lds, unsigned char* ws, unsigned* ctl, LAS int* tb, LAS int* cntl, int G, int tid, int wave, int lane, int gw, int NGW) {
    {
        pg8::Gemm g{ws + WS_YA, ws + WS_WRO, RW}; pg8::StaticOrder S; S.init(M, D, G, (int)blockIdx.x);
        EpiYa E{(bf16*)(ws + WS_YAO)};
        pg8::gemm_phase<EpiYa, pg8::StaticOrder, true>(lds, g, S, E); }
    {
        pg8::Gemm g{ws + WS_Z, ws + WS_WGL, S5W, (127 - GLU_Z_SH) * 0x01010101, (127 - GLU_W_SH) * 0x01010101}; pg8::StaticOrder S; S.init(M, 2 * D, G, (int)blockIdx.x);
        EpiGlu E{(bf16*)(ws + WS_YBO)};
        pg8::gemm_phase<EpiGlu, pg8::StaticOrder, true, true>(lds, g, S, E); }
}
__device__ __forceinline__ void phase_5(const Params& p, LAS unsigned char* lds, unsigned char* ws, unsigned* ctl, LAS int* tb, LAS int* cntl, int G, int tid, int wave, int lane, int gw, int NGW) {
    pg8::Gemm g{ws + WS_H28, ws + WS_WIN8, D, 127 * 0x01010101, (127 - MOE_WGU_SH) * 0x01010101}; pg8::StaticOrder S; S.init(M, 2 * D, G, (int)blockIdx.x);
    EpiMerge E{(const bf16*)(ws + WS_YAO), (const bf16*)(ws + WS_YBO), ws + WS_MIX};
    pg8::gemm_phase<EpiMerge, pg8::StaticOrder, true, true>(lds, g, S, E);
}
__device__ __forceinline__ void phase_6(const Params& p, LAS unsigned char* lds, unsigned char* ws, unsigned* ctl, LAS int* tb, LAS int* cntl, int G, int tid, int wave, int lane, int gw, int NGW) { pg8::Gemm g{ws + WS_MIX, ws + WS_WO, D, (127 - MIX_SH) * 0x01010101, (127 - WO_W_SH) * 0x01010101}; pg8::StaticOrder S; S.init(M, D, G, (int)blockIdx.x);
        EpiX1 E{p.in[I_X], (bf16*)(ws + WS_X1)};
        pg8::gemm_phase<EpiX1, pg8::StaticOrder, true, true>(lds, g, S, E); }
__device__ __forceinline__ void phase_7(const Params& p, LAS unsigned char* lds, unsigned char* ws, unsigned* ctl, LAS int* tb, LAS int* cntl, int G, int tid, int wave, int lane, int gw, int NGW) { p7_norm_route(p, lds, tid, wave, lane); }
__device__ __forceinline__ void phase_10(const Params& p, LAS unsigned char* lds, unsigned char* ws, unsigned* ctl, LAS int* tb, LAS int* cntl, int G, int tid, int wave, int lane, int gw, int NGW) { moe_tables(ctl + CW_CNT, tb, cntl, tid);
        pg8::Gemm g{ws + WS_H28, ws + WS_MGU, D, 127 * 0x01010101, (127 - MOE_WGU_SH) * 0x01010101}; MoeOrder S{tb, cntl, (const int*)(ws + WS_LIST), 4, G, (int)blockIdx.x, true};
        EpiMoeGU E{ws + WS_HID};
        pg8::gemm_phase<EpiMoeGU, MoeOrder, true, true>(lds, g, S, E); }
__device__ __forceinline__ void phase_11(const Params& p, LAS unsigned char* lds, unsigned char* ws, unsigned* ctl, LAS int* tb, LAS int* cntl, int G, int tid, int wave, int lane, int gw, int NGW) { moe_tables(ctl + CW_CNT, tb, cntl, tid);
        pg8::Gemm g{ws + WS_HID, ws + WS_MD, DEXP, (127 - MOE_HID_SH) * 0x01010101, (127 - MOE_WD_SH) * 0x01010101}; MoeOrder S{tb, cntl, (const int*)(ws + WS_LIST), 8, G, (int)blockIdx.x, false};
        EpiMoeDown E{ws + WS_Y2};
        pg8::gemm_phase<EpiMoeDown, MoeOrder, true, true>(lds, g, S, E); }
__device__ __forceinline__ void phase_12(const Params& p, LAS unsigned char* lds, unsigned char* ws, unsigned* ctl, LAS int* tb, LAS int* cntl, int G, int tid, int wave, int lane, int gw, int NGW) { moe_tables(ctl + CW_CNT, tb, cntl, tid); p11_final(p, tb, gw, NGW, lane); }

#ifndef MK_ONE_LAUNCH
#define MK_ONE_LAUNCH 1
#endif
constexpr int N_PHASES = 13;
__global__ void __launch_bounds__(NTHR, 2) hyb_fwd(Params p) {
    extern __shared__ __attribute__((aligned(16))) unsigned char lds_raw[];
    LAS unsigned char* lds = (LAS unsigned char*)lds_raw;
    const int tid = threadIdx.x, lane = tid & 63, wave = __builtin_amdgcn_readfirstlane(tid >> 6);
    const int G = gridDim.x;
    const int gw = blockIdx.x * NWAVES + wave, NGW = G * NWAVES;
    unsigned char* ws = p.ws;
    unsigned* ctl = (unsigned*)(ws + WS_CTL);
    LAS unsigned char* lds0 = lds; lds = lds0 + RING_OFF;
    for (int u = tid; u < RING_OFF / 4; u += NTHR) ((LAS unsigned*)(lds0 + LDSCTL_OFF))[u] = 0u;
    __syncthreads();
    LAS int* tb = (LAS int*)(lds0 + LDSCTL_OFF); LAS int* cntl = tb + 40;
    volatile LAS unsigned* MISC = (volatile LAS unsigned*)(lds0 + MISC_OFF);
    const int lo = p.ph_lo, hi = p.ph_hi;
    XcdBarrier bar; bar.bar = ctl + CW_BAR; bar.x = 0; bar.st = nullptr;
    if (hi - lo > 1) bar = xcd_barrier_post(ctl + CW_BAR, MISC + 8);
#define IN(k) (lo <= (k) && (k) < hi)
#define SEAM(k) do { if (IN(k) && IN((k) + 1)) xcd_barrier(bar); } while (0)

    if (IN(0)) { phase_0(p, lds, ws, ctl, tb, cntl, G, tid, wave, lane, gw, NGW); }
    SEAM(0);
    if (IN(1)) { phase_1(p, lds, ws, ctl, tb, cntl, G, tid, wave, lane, gw, NGW); }
    SEAM(1);
    if (IN(2)) { phase_2(p, lds, ws, ctl, tb, cntl, G, tid, wave, lane, gw, NGW); }
    SEAM(2);
    if (IN(3)) { phase_3(p, lds, ws, ctl, tb, cntl, G, tid, wave, lane, gw, NGW); }
    SEAM(3);
    if (IN(4)) { phase_4(p, lds, ws, ctl, tb, cntl, G, tid, wave, lane, gw, NGW); }
    SEAM(4);
    if (IN(5)) { phase_5(p, lds, ws, ctl, tb, cntl, G, tid, wave, lane, gw, NGW); }
    SEAM(5);
    if (IN(6)) { phase_6(p, lds, ws, ctl, tb, cntl, G, tid, wave, lane, gw, NGW); }
    SEAM(6);
    if (IN(7)) { phase_7(p, lds, ws, ctl, tb, cntl, G, tid, wave, lane, gw, NGW); }
    SEAM(7);
    if (IN(10)) { phase_10(p, lds, ws, ctl, tb, cntl, G, tid, wave, lane, gw, NGW); }
    SEAM(10);
    if (IN(11)) { phase_11(p, lds, ws, ctl, tb, cntl, G, tid, wave, lane, gw, NGW); }
    SEAM(11);
    if (IN(12)) { phase_12(p, lds, ws, ctl, tb, cntl, G, tid, wave, lane, gw, NGW); }
#undef IN
#undef SEAM
}

extern "C" void kernel_launch(void* const* d_in, const int* in_sizes, int n_in, void* d_out, int out_size, void* d_ws, size_t ws_size, hipStream_t stream) {
    static int grid = 0;
    if (grid == 0) {
        if (n_in != 35 || out_size != M * D || ws_size < WS_END) { fprintf(stderr, "kernel_launch: unexpected problem (n_in %d out %d ws %zu, need %zu)\n", n_in, out_size, ws_size, (size_t)WS_END); grid = -1; return; }
        int dev = 0, cus = 0, per_cu = 0;
        if (hipGetDevice(&dev) != hipSuccess || hipDeviceGetAttribute(&cus, hipDeviceAttributeMultiprocessorCount, dev) != hipSuccess) { grid = -1; return; }
        if (hipFuncSetAttribute((const void*)hyb_fwd, hipFuncAttributeMaxDynamicSharedMemorySize, LDS_BYTES) != hipSuccess) { fprintf(stderr, "kernel_launch: hipFuncSetAttribute failed\n"); grid = -1; return; }
        if (hipOccupancyMaxActiveBlocksPerMultiprocessor(&per_cu, (const void*)hyb_fwd, NTHR, LDS_BYTES) != hipSuccess || per_cu < 1) fprintf(stderr, "kernel_launch: occupancy query says %d\n", per_cu);
        (void)hipGetLastError();
        grid = cus;
    }
    if (grid < 0) return;
    if (hipMemsetAsync((char*)d_ws + WS_CTL, 0, CTL_ZERO_BYTES, stream) != hipSuccess) return;
    Params p{};
    for (int i = 0; i < 35; ++i) p.in[i] = (const float*)d_in[i];
    p.out = (float*)d_out; p.ws = (unsigned char*)d_ws;
#if MK_ONE_LAUNCH
    p.ph_lo = 0; p.ph_hi = N_PHASES;
    hipLaunchKernelGGL(hyb_fwd, dim3(grid), dim3(NTHR), LDS_BYTES, stream, p);
#else
    for (int ph = 0; ph < N_PHASES; ++ph) { p.ph_lo = ph; p.ph_hi = ph + 1; hipLaunchKernelGGL(hyb_fwd, dim3(grid), dim3(NTHR), LDS_BYTES, stream, p); }
#endif
}
```
